# Optimizing an MI355X kernel written in HIP

```python
import jax, jax.numpy as jnp
from jax import lax
import numpy as np

D_MODEL = 1024
BATCH = 8
SEQ = 4096
DEPTH = 4

FOX_HEADS = 16
FOX_HEAD_DIM = D_MODEL // FOX_HEADS
FOX_WIDTH = FOX_HEADS * FOX_HEAD_DIM
FOX_FORGET_BIAS = 3.0
Q_BLOCK = 128
HG_HEADS = 8
HG_KEY_DIM = 128
HG_VAL_DIM = D_MODEL // HG_HEADS
HG_KEY_WIDTH = HG_HEADS * HG_KEY_DIM
HG_VAL_WIDTH = HG_HEADS * HG_VAL_DIM
HG_CHUNK = 64
COL_SIZES = (FOX_WIDTH, FOX_WIDTH, FOX_WIDTH, FOX_HEADS, HG_KEY_WIDTH, HG_KEY_WIDTH, HG_VAL_WIDTH, HG_VAL_WIDTH, D_MODEL, D_MODEL)
D_IN = 3 * FOX_WIDTH + FOX_HEADS + 2 * HG_KEY_WIDTH + 2 * HG_VAL_WIDTH + 2 * D_MODEL
D_FF_DENSE = 2816
N_EXPERTS = 8
TOP_K = 2
D_FF_EXPERT = 3584
N_DENSE = (DEPTH + 1) // 2
N_MOE = DEPTH // 2
N_ADA = 6
EPS = 1e-6
F_MIN = 1e-20
MASK_NEG = -1e30
F32 = jnp.float32

kernel_name = "fox_hgrn2_gated_hybrid_moe_adaln"


def rms_norm(x, gain):
    xf = x.astype(F32)
    y = xf * lax.rsqrt(jnp.mean(xf * xf, axis=-1, keepdims=True) + EPS)
    return (y * gain.astype(F32)).astype(x.dtype)


def swiglu(t, w_gate, w_up, w_down):
    return (jax.nn.silu(t @ w_gate) * (t @ w_up)) @ w_down


def forgetting_attention(q, k, v, log_f):
    B, S, H, dh = q.shape
    nb = S // Q_BLOCK
    F = jnp.cumsum(log_f, axis=1)
    F_k = F.transpose(0, 2, 1)[:, :, None, :]
    qb = q.reshape(B, nb, Q_BLOCK, H, dh).transpose(1, 0, 2, 3, 4)
    Fb = F.reshape(B, nb, Q_BLOCK, H).transpose(1, 0, 3, 2)
    k_pos = jnp.arange(S)
    scale = dh ** -0.5

    def block(args):
        i, q_i, F_i = args
        s = jnp.einsum('bqhd,bkhd->bhqk', q_i, k, preferred_element_type=F32) * scale
        s = s + F_i[..., None] - F_k
        q_pos = i * Q_BLOCK + jnp.arange(Q_BLOCK)
        mask = k_pos[None, :] <= q_pos[:, None]
        p = jax.nn.softmax(jnp.where(mask, s, MASK_NEG), axis=-1)
        return jnp.einsum('bhqk,bkhd->bqhd', p.astype(v.dtype), v)

    o = lax.map(block, (jnp.arange(nb), qb, Fb))
    return o.transpose(1, 0, 2, 3, 4).reshape(B, S, H * dh)


def hgrn2_recurrence(q, k, v, log_f):
    B, S, H, dk = q.shape
    dv = v.shape[-1]
    n = S // HG_CHUNK

    def to_chunks(t):
        return t.astype(F32).reshape(B, n, HG_CHUNK, H, t.shape[-1]).transpose(1, 0, 3, 2, 4)

    qc, kc, vc, gc = to_chunks(q), to_chunks(k), to_chunks(v), to_chunks(log_f)
    causal = jnp.tril(jnp.ones((HG_CHUNK, HG_CHUNK), bool))[..., None]

    def step(state, inp):
        q_c, k_c, v_c, g_c = inp
        G = jnp.cumsum(g_c, axis=2)
        diff = G[:, :, :, None, :] - G[:, :, None, :, :]
        decay = jnp.where(causal, jnp.exp(jnp.where(causal, diff, 0.0)), 0.0)
        A = jnp.einsum('bhtk,bhsk,bhtsk->bhts', q_c, k_c, decay)
        o = jnp.einsum('bhts,bhsv->bhtv', A, v_c) + jnp.einsum('bhtk,bhkv->bhtv', q_c * jnp.exp(G), state)
        G_last = G[:, :, -1:, :]
        state = state * jnp.exp(G_last[:, :, 0, :])[..., None] + jnp.einsum('bhsk,bhsv->bhkv', k_c * jnp.exp(G_last - G), v_c)
        return state, o

    s0 = jnp.zeros((B, H, dk, dv), F32)
    _, o = lax.scan(step, s0, (qc, kc, vc, gc))
    return o.transpose(1, 0, 3, 2, 4).reshape(B, S, H, dv).astype(v.dtype)


def hybrid_mixer(h, w_in, q_gain, k_gain, f_bias, lb, o_gain, w_out):
    B, S, _ = h.shape
    proj = h @ w_in
    offs = np.cumsum(COL_SIZES)[:-1].tolist()
    fq, fk, fv, ff, hq, hf, hi, hg, ga, gb = jnp.split(proj, offs, axis=-1)
    fq = rms_norm(fq.reshape(B, S, FOX_HEADS, FOX_HEAD_DIM), q_gain)
    fk = rms_norm(fk.reshape(B, S, FOX_HEADS, FOX_HEAD_DIM), k_gain)
    fv = fv.reshape(B, S, FOX_HEADS, FOX_HEAD_DIM)
    fox_log_f = jax.nn.log_sigmoid((ff + f_bias).astype(F32))
    o_a = forgetting_attention(fq, fk, fv, fox_log_f)
    z = hf.reshape(B, S, HG_HEADS, HG_KEY_DIM).astype(F32)
    lb_h = lb.reshape(HG_HEADS, HG_KEY_DIM).astype(F32)
    hg_f = lb_h + (1.0 - lb_h) * jax.nn.sigmoid(z)
    hg_log_f = jnp.log(jnp.maximum(hg_f, F_MIN))
    hg_k = (1.0 - lb_h) * jax.nn.sigmoid(-z)
    hg_q = jax.nn.silu(hq).reshape(B, S, HG_HEADS, HG_KEY_DIM)
    hg_v = hi.reshape(B, S, HG_HEADS, HG_VAL_DIM)
    o_h = hgrn2_recurrence(hg_q, hg_k, hg_v, hg_log_f)
    o_b = (rms_norm(o_h, o_gain) * jax.nn.silu(hg.reshape(B, S, HG_HEADS, HG_VAL_DIM))).reshape(B, S, D_MODEL)
    y = jax.nn.sigmoid(ga) * o_a.astype(h.dtype) + jax.nn.sigmoid(gb) * o_b.astype(h.dtype)
    return y @ w_out


def moe_swiglu(h, w_router, b_router, w_gate, w_up, w_down):
    B, S, D = h.shape
    t = h.reshape(B * S, D)
    logits = (t @ w_router).astype(F32) + b_router.astype(F32)
    top_val, top_idx = lax.top_k(logits, TOP_K)
    top_w = jax.nn.softmax(top_val, axis=-1)
    combine = jnp.sum(jax.nn.one_hot(top_idx, N_EXPERTS, dtype=F32) * top_w[..., None], axis=1)
    out = jnp.zeros((B * S, D), F32)
    for e in range(N_EXPERTS):
        out = out + combine[:, e:e + 1] * swiglu(t, w_gate[e], w_up[e], w_down[e]).astype(F32)
    return out.astype(h.dtype).reshape(B, S, D)


def setup_inputs(seed: int = 0) -> dict:
    key = jax.random.key(seed)
    ks = jax.random.split(key, 24)

    def nrm(k, shape, s):
        return jax.random.normal(k, shape, F32) * s

    return {
        "x": nrm(ks[0], (BATCH, SEQ, D_MODEL), 1.0),
        "c": nrm(ks[1], (BATCH, D_MODEL), 1.0),
        "w_ada": nrm(ks[2], (DEPTH, D_MODEL, N_ADA * D_MODEL), 0.3 * D_MODEL ** -0.5),
        "b_ada": nrm(ks[3], (DEPTH, N_ADA * D_MODEL), 0.02),
        "norm_mix": 1.0 + nrm(ks[4], (DEPTH, D_MODEL), 0.02),
        "norm_ffn": 1.0 + nrm(ks[5], (DEPTH, D_MODEL), 0.02),
        "w_in": nrm(ks[6], (DEPTH, D_MODEL, D_IN), D_MODEL ** -0.5),
        "fox_q_gain": 1.0 + nrm(ks[7], (DEPTH, FOX_HEAD_DIM), 0.02),
        "fox_k_gain": 1.0 + nrm(ks[8], (DEPTH, FOX_HEAD_DIM), 0.02),
        "fox_f_bias": FOX_FORGET_BIAS + nrm(ks[9], (DEPTH, FOX_HEADS), 0.5),
        "hg_lb": nrm(ks[10], (DEPTH, HG_KEY_WIDTH), 0.1),
        "hg_o_gain": 1.0 + nrm(ks[11], (DEPTH, HG_VAL_DIM), 0.02),
        "w_out": nrm(ks[12], (DEPTH, D_MODEL, D_MODEL), D_MODEL ** -0.5),
        "w_router": nrm(ks[13], (N_MOE, D_MODEL, N_EXPERTS), D_MODEL ** -0.5),
        "b_router": nrm(ks[14], (N_MOE, N_EXPERTS), 0.01),
        "dense_w_gate": nrm(ks[15], (N_DENSE, D_MODEL, D_FF_DENSE), D_MODEL ** -0.5),
        "dense_w_up": nrm(ks[16], (N_DENSE, D_MODEL, D_FF_DENSE), D_MODEL ** -0.5),
        "dense_w_down": nrm(ks[17], (N_DENSE, D_FF_DENSE, D_MODEL), D_FF_DENSE ** -0.5),
        "moe_w_gate": nrm(ks[18], (N_MOE, N_EXPERTS, D_MODEL, D_FF_EXPERT), D_MODEL ** -0.5),
        "moe_w_up": nrm(ks[19], (N_MOE, N_EXPERTS, D_MODEL, D_FF_EXPERT), D_MODEL ** -0.5),
        "moe_w_down": nrm(ks[20], (N_MOE, N_EXPERTS, D_FF_EXPERT, D_MODEL), D_FF_EXPERT ** -0.5),
    }


def reference(x, c, w_ada, b_ada, norm_mix, norm_ffn, w_in, fox_q_gain, fox_k_gain, fox_f_bias, hg_lb, hg_o_gain,
              w_out, w_router, b_router, dense_w_gate, dense_w_up, dense_w_down, moe_w_gate, moe_w_up, moe_w_down):
    c_act = jax.nn.silu(c)
    lb_sm = jax.nn.softmax(hg_lb.astype(F32), axis=0)
    lb_all = jnp.cumsum(lb_sm, axis=0) - lb_sm[0:1]
    for layer in range(DEPTH):
        ada = c_act @ w_ada[layer] + b_ada[layer]
        sh1, sc1, g1, sh2, sc2, g2 = jnp.split(ada[:, None, :], N_ADA, axis=-1)
        h = rms_norm(x, norm_mix[layer]) * (1.0 + sc1) + sh1
        x = x + g1 * hybrid_mixer(h, w_in[layer], fox_q_gain[layer], fox_k_gain[layer], fox_f_bias[layer],
                                  lb_all[layer], hg_o_gain[layer], w_out[layer])
        h = rms_norm(x, norm_ffn[layer]) * (1.0 + sc2) + sh2
        if layer % 2 == 0:
            i = layer // 2
            f = swiglu(h, dense_w_gate[i], dense_w_up[i], dense_w_down[i])
        else:
            i = layer // 2
            f = moe_swiglu(h, w_router[i], b_router[i], moe_w_gate[i], moe_w_up[i], moe_w_down[i])
        x = x + g2 * f
    return x
```

```cpp
#include <hip/hip_runtime.h>
#include <hip/hip_bf16.h>
#include <cstdio>
#include <cstdint>
#include <cmath>
namespace pg8 {
#define PG8_LAS __attribute__((address_space(3)))
typedef unsigned short bf16_t;
typedef short bf16x8 __attribute__((ext_vector_type(8)));
typedef float f32x4 __attribute__((ext_vector_type(4)));
typedef unsigned u32x4 __attribute__((ext_vector_type(4)));
constexpr int BM = 256, BK = 64, HALF = 128, HTB = HALF * BK * 2  , STAGE_BYTES = 8 * HTB, NXCD = 8, WGM = 8;

__host__ __device__ __forceinline__ int lds_byte(int r, int c) { const int st = (r >> 4) * 2 + (c >> 5), rr = r & 15, cc = c & 31, ob = rr * 64 + cc * 2; return st * 1024 + (ob ^ (((ob >> 9) & 1) << 5)); }
__host__ __device__ __forceinline__ void stage_rc(int b, int& R, int& C) { const int st = b / 1024, sb = b % 1024, swz = sb ^ (((sb >> 9) & 1) << 5); R = (st >> 1) * 16 + swz / 64; C = (st & 1) * 32 + (swz % 64) / 2; }
__host__ __device__ __forceinline__ int perm32(int rho) { const int n = rho >> 4, i = rho & 15; return 8 * (i >> 2) + 4 * n + (i & 3); }

struct Unit { int pm, pn, pb; };
struct Gemm { const bf16_t* A; const bf16_t* Bt; int M, N, K; };

struct TileOrder {
    int nM, nN, nwg, G, c, nbt; int cum[8];
    __device__ __forceinline__ void init(int nM_, int nN_, int G_, int c_) { nM = nM_; nN = nN_; nwg = nM * nN; G = G_; c = c_; nbt = 0;
#pragma unroll
        for (int k = 0; k < 8; ++k) cum[k] = 0x7fffffff; }
    __device__ __forceinline__ bool next(int i, Unit& u) const {
        const long L = (long)i * G + c; if (L >= nwg) return false;
        int wgid = (int)L; { const int q = nwg / NXCD, r = nwg % NXCD, xcd = wgid % NXCD, off = wgid / NXCD; wgid = (xcd < r ? xcd * (q + 1) : r * (q + 1) + (xcd - r) * q) + off; }
        const int nig = WGM * nN, gid = wgid / nig, fm = gid * WGM, gsz = (nM - fm) < WGM ? (nM - fm) : WGM;
        u.pm = fm + ((wgid % nig) % gsz); u.pn = (wgid % nig) / gsz;
        int e = 0;
#pragma unroll
        for (int k = 1; k < 8; ++k) e += (u.pm >= cum[k]) ? 1 : 0;
        u.pb = e * nbt + u.pn; return true;
    }
    __device__ __forceinline__ void a_ready(const Unit&) const {}
    __device__ __forceinline__ void done(const Unit&) const {}
};

__device__ __forceinline__ unsigned cvt_pk_bf16(float lo, float hi) { unsigned r; asm volatile("v_cvt_pk_bf16_f32 %0, %1, %2" : "=v"(r) : "v"(lo), "v"(hi)); return r; }
__device__ __forceinline__ float sigmoid_f(float v) { return __builtin_amdgcn_rcpf(1.0f + __builtin_amdgcn_exp2f(-1.4426950408889634f * v)); }
__device__ __forceinline__ f32x4 sigmoid4(f32x4 v) { return (f32x4){sigmoid_f(v[0]), sigmoid_f(v[1]), sigmoid_f(v[2]), sigmoid_f(v[3])}; }

struct EpiInProj {
    static constexpr bool PERM = true, AFTER_DRAIN = false;
    bf16_t* base; size_t bufstride; float* LF; const float* fbias;
    __device__ __forceinline__ void operator()(const f32x4 (&acc)[2][2][4][2], const Unit& u, int wr, int wc, int fr, int fq) const {
        const int row0 = u.pm * BM + wr * 64 + fr;
        if (u.pn < 36) {
            const int t = u.pn >> 2; const int act = (t == 3 || t == 6) ? 1 : (t >= 7 ? 2 : 0);
            bf16_t* b = base + (size_t)t * bufstride; const int col0 = (u.pn & 3) * 256 + wc * 32 + 8 * fq;
#pragma unroll
            for (int ai = 0; ai < 2; ++ai)
#pragma unroll
                for (int m = 0; m < 4; ++m) { bf16_t* rowp = b + (size_t)(row0 + ai * HALF + m * 16) * 1024 + col0;
#pragma unroll
                    for (int bj = 0; bj < 2; ++bj) { f32x4 v0 = acc[ai][bj][m][0], v1 = acc[ai][bj][m][1];
                        if (act != 0) { const f32x4 s0 = sigmoid4(v0), s1 = sigmoid4(v1); if (act == 1) { v0 = v0 * s0; v1 = v1 * s1; } else { v0 = s0; v1 = s1; } }
                        u32x4 w; w.x = cvt_pk_bf16(v0[0], v0[1]); w.y = cvt_pk_bf16(v0[2], v0[3]); w.z = cvt_pk_bf16(v1[0], v1[1]); w.w = cvt_pk_bf16(v1[2], v1[3]);
                        *(u32x4*)(rowp + bj * HALF) = w; } }
        } else if (wc == 0 && fq < 2) {
#pragma unroll
            for (int n = 0; n < 2; ++n) { const f32x4 bv = *(const f32x4*)(fbias + 8 * fq + 4 * n);
#pragma unroll
                for (int ai = 0; ai < 2; ++ai)
#pragma unroll
                    for (int m = 0; m < 4; ++m) { const f32x4 x = acc[ai][0][m][n] + bv; f32x4 o;
#pragma unroll
                        for (int j = 0; j < 4; ++j) o[j] = fminf(x[j], 0.f) - log1pf(expf(-fabsf(x[j])));
                        *(f32x4*)(LF + (size_t)(row0 + ai * HALF + m * 16) * 16 + 8 * fq + 4 * n) = o; } }
        }
    }
};

struct EpiResid {
    static constexpr bool PERM = true, AFTER_DRAIN = false;
    const float* base; float* out; const float* gate; int gstride; bf16_t* O; int mode;
    __device__ __forceinline__ void operator()(const f32x4 (&acc)[2][2][4][2], const Unit& u, int wr, int wc, int fr, int fq) const {
        const int row0 = u.pm * BM + wr * 64 + fr, col0 = u.pn * BM + wc * 32 + 8 * fq;
        if (mode == 0) {
            const float* g = gate + (size_t)((u.pm * BM) >> 12) * gstride + col0;
            f32x4 gv[2][2];
#pragma unroll
            for (int bj = 0; bj < 2; ++bj)
#pragma unroll
                for (int n = 0; n < 2; ++n) gv[bj][n] = *(const f32x4*)(g + bj * HALF + 4 * n);
#pragma unroll
            for (int ai = 0; ai < 2; ++ai)
#pragma unroll
                for (int m = 0; m < 4; ++m) { const size_t off = (size_t)(row0 + ai * HALF + m * 16) * 1024 + col0;
#pragma unroll
                    for (int bj = 0; bj < 2; ++bj)
#pragma unroll
                        for (int n = 0; n < 2; ++n) { const f32x4 bs = *(const f32x4*)(base + off + bj * HALF + 4 * n); *(f32x4*)(out + off + bj * HALF + 4 * n) = bs + gv[bj][n] * acc[ai][bj][m][n]; }
                    asm volatile("" ::: "memory"); }
        } else {
#pragma unroll
            for (int ai = 0; ai < 2; ++ai)
#pragma unroll
                for (int m = 0; m < 4; ++m) { bf16_t* rowp = O + (size_t)(row0 + ai * HALF + m * 16) * 1024 + col0;
#pragma unroll
                    for (int bj = 0; bj < 2; ++bj) { const f32x4 v0 = acc[ai][bj][m][0], v1 = acc[ai][bj][m][1];
                        u32x4 w; w.x = cvt_pk_bf16(v0[0], v0[1]); w.y = cvt_pk_bf16(v0[2], v0[3]); w.z = cvt_pk_bf16(v1[0], v1[1]); w.w = cvt_pk_bf16(v1[2], v1[3]);
                        *(u32x4*)(rowp + bj * HALF) = w; } }
        }
    }
};

struct EpiSwiGLU {
    static constexpr bool PERM = true, AFTER_DRAIN = false;
    bf16_t* O; int ldc;
    __device__ __forceinline__ void operator()(const f32x4 (&acc)[2][2][4][2], const Unit& u, int wr, int wc, int fr, int fq) const {
        const int row0 = u.pm * BM + wr * 64 + fr, col0 = u.pn * HALF + wc * 32 + 8 * fq;
#pragma unroll
        for (int ai = 0; ai < 2; ++ai)
#pragma unroll
            for (int m = 0; m < 4; ++m) { bf16_t* rowp = O + (size_t)(row0 + ai * HALF + m * 16) * ldc + col0;
                const f32x4 g0 = acc[ai][0][m][0], g1 = acc[ai][0][m][1], u0 = acc[ai][1][m][0], u1 = acc[ai][1][m][1];
                const f32x4 h0 = g0 * sigmoid4(g0) * u0, h1 = g1 * sigmoid4(g1) * u1;
                u32x4 w; w.x = cvt_pk_bf16(h0[0], h0[1]); w.y = cvt_pk_bf16(h0[2], h0[3]); w.z = cvt_pk_bf16(h1[0], h1[1]); w.w = cvt_pk_bf16(h1[2], h1[3]);
                *(u32x4*)rowp = w; }
    }
};

template <class Epi, class Sched, bool ALIGN_EPI = false, bool SP2 = false>
__device__ __forceinline__ void gemm_phase(PG8_LAS unsigned char* lds, const Gemm g, const Sched& S, const Epi& E, const int tid) {
    const int wid = __builtin_amdgcn_readfirstlane(tid >> 6), lane = tid & 63, wr = wid >> 2, wc = wid & 3, fr = lane & 15, fq = lane >> 4;
    const int K = g.K, nt = K / BK;
    unsigned voffA[2], voffB[2];
#pragma unroll
    for (int i = 0; i < 2; ++i) { int R, C; stage_rc(tid * 16 + i * 8192, R, C); const int Rb = Epi::PERM ? ((R & ~31) + perm32(R & 31)) : R;
        voffA[i] = (unsigned)(R * K + C) * 2u; voffB[i] = (unsigned)(Rb * K + C) * 2u; }
    const size_t kstep = (size_t)(BK * 2);
    const size_t hstep = (size_t)HALF * K * 2;
    const size_t tstep = 2 * hstep;
    const unsigned ldsw = (unsigned)wid * 1024u;
    const int aoff = lds_byte(wr * 64 + fr, fq * 8), boff = lds_byte(wc * 32 + fr, fq * 8);
#define PG8_SA(b, h) (((b) * 2 + (h)) * HTB)
#define PG8_SB(b, h) ((4 + (b) * 2 + (h)) * HTB)
#define PG8_STAGE(bufoff, gbase, voff) do { _Pragma("unroll") for (int _i = 0; _i < 2; ++_i) \
        __builtin_amdgcn_global_load_lds((const unsigned*)((const char*)(gbase) + (voff)[_i]), (PG8_LAS unsigned*)(lds + (bufoff) + ldsw + _i * 8192), 16, 0, 0); } while (0)
#define PG8_LDA(dst, b, h) do { _Pragma("unroll") for (int m = 0; m < 4; ++m) _Pragma("unroll") for (int k = 0; k < 2; ++k) dst[m][k] = *(const PG8_LAS bf16x8*)(lds + PG8_SA(b, h) + aoff + m * 2048 + k * 1024); } while (0)
#define PG8_LDB(dst, b, h) do { _Pragma("unroll") for (int n = 0; n < 2; ++n) _Pragma("unroll") for (int k = 0; k < 2; ++k) dst[n][k] = *(const PG8_LAS bf16x8*)(lds + PG8_SB(b, h) + boff + n * 2048 + k * 1024); } while (0)
#define PG8_MMA(ai, bj, At, Bt) do { __builtin_amdgcn_s_setprio(1); _Pragma("unroll") for (int m = 0; m < 4; ++m) _Pragma("unroll") for (int n = 0; n < 2; ++n) _Pragma("unroll") for (int k = 0; k < 2; ++k) \
        acc[ai][bj][m][n] = __builtin_amdgcn_mfma_f32_16x16x32_bf16(Bt[n][k], At[m][k], acc[ai][bj][m][n], 0, 0, 0); __builtin_amdgcn_s_setprio(0); } while (0)
#define PG8_WAIT_V(n) asm volatile("s_waitcnt vmcnt(" #n ")" ::: "memory")
#define PG8_WAIT_L(n) asm volatile("s_waitcnt lgkmcnt(" #n ")" ::: "memory")
#define PG8_BAR __builtin_amdgcn_s_barrier()
#define PG8_SCHED __builtin_amdgcn_sched_barrier(0)
    Unit cur, nxt; int ui = 0;
    if (!S.next(0, cur)) return;
    f32x4 acc[2][2][4][2];
#pragma unroll
    for (int a = 0; a < 2; ++a)
#pragma unroll
        for (int b = 0; b < 2; ++b)
#pragma unroll
            for (int m = 0; m < 4; ++m)
#pragma unroll
                for (int n = 0; n < 2; ++n) acc[a][b][m][n] = (f32x4){0.f, 0.f, 0.f, 0.f};
    bf16x8 At[4][2], B0[2][2], B1[2][2];
    const char* cA = (const char*)g.A + (size_t)cur.pm * tstep; const char* cB = (const char*)g.Bt + (size_t)cur.pb * tstep;
    S.a_ready(cur);
    if constexpr (SP2) {
        PG8_STAGE(PG8_SB(0, 0), cB, voffB); PG8_STAGE(PG8_SB(0, 1), cB + hstep, voffB); PG8_STAGE(PG8_SA(0, 0), cA, voffA); PG8_STAGE(PG8_SA(0, 1), cA + hstep, voffA);
        if (wr == 1) PG8_BAR;
        PG8_WAIT_V(2); PG8_BAR;
        PG8_STAGE(PG8_SB(1, 0), cB + kstep, voffB); PG8_STAGE(PG8_SA(1, 0), cA + kstep, voffA); PG8_STAGE(PG8_SB(1, 1), cB + hstep + kstep, voffB);
        PG8_WAIT_V(6); PG8_BAR;
    } else {
        PG8_STAGE(PG8_SB(0, 0), cB, voffB); PG8_STAGE(PG8_SA(0, 0), cA, voffA); PG8_STAGE(PG8_SB(0, 1), cB + hstep, voffB); PG8_STAGE(PG8_SA(0, 1), cA + hstep, voffA);
        if (wr == 1) PG8_BAR;
        PG8_WAIT_V(4); PG8_BAR;
        PG8_STAGE(PG8_SB(1, 0), cB + kstep, voffB); PG8_STAGE(PG8_SA(1, 0), cA + kstep, voffA); PG8_STAGE(PG8_SB(1, 1), cB + hstep + kstep, voffB);
        PG8_WAIT_V(6); PG8_BAR;
    }
    for (;;) {
        const bool has_next = S.next(ui + 1, nxt);
        const char* nA = has_next ? (const char*)g.A + (size_t)nxt.pm * tstep : cA; const char* nB = has_next ? (const char*)g.Bt + (size_t)nxt.pb * tstep : cB;
        for (int t = 0; t < nt; t += 2) {
            const bool last = (t == nt - 2);
            const char* a1 = cA + (size_t)(t + 1) * kstep;
            const char* a2 = last ? nA : cA + (size_t)(t + 2) * kstep; const char* b2 = last ? nB : cB + (size_t)(t + 2) * kstep;
            const char* a3 = a2 + kstep; const char* b3 = b2 + kstep;
            if (last && has_next) S.a_ready(nxt);
            if constexpr (SP2) {
            PG8_LDB(B0, 0, 0); PG8_LDB(B1, 0, 1); PG8_SCHED; PG8_LDA(At, 0, 0); PG8_STAGE(PG8_SA(1, 1), a1 + hstep, voffA);
            PG8_WAIT_V(8); PG8_WAIT_L(0); PG8_BAR; PG8_MMA(0, 0, At, B0); PG8_MMA(0, 1, At, B1); PG8_BAR; PG8_SCHED;
            PG8_LDA(At, 0, 1); PG8_STAGE(PG8_SB(0, 0), b2, voffB); PG8_STAGE(PG8_SB(0, 1), b2 + hstep, voffB); PG8_STAGE(PG8_SA(0, 0), a2, voffA);
            PG8_WAIT_V(8); PG8_WAIT_L(0); PG8_BAR; PG8_MMA(1, 0, At, B0); PG8_MMA(1, 1, At, B1); PG8_BAR; PG8_SCHED;
            PG8_LDB(B0, 1, 0); PG8_LDB(B1, 1, 1); PG8_SCHED; PG8_LDA(At, 1, 0); PG8_STAGE(PG8_SA(0, 1), a2 + hstep, voffA);
            PG8_WAIT_V(8); PG8_WAIT_L(0); PG8_BAR; PG8_MMA(0, 0, At, B0); PG8_MMA(0, 1, At, B1); PG8_BAR; PG8_SCHED;
            PG8_LDA(At, 1, 1); PG8_STAGE(PG8_SB(1, 0), b3, voffB); PG8_STAGE(PG8_SB(1, 1), b3 + hstep, voffB); PG8_STAGE(PG8_SA(1, 0), a3, voffA);
            PG8_WAIT_V(8); PG8_WAIT_L(0); PG8_BAR; PG8_MMA(1, 0, At, B0); PG8_MMA(1, 1, At, B1); PG8_BAR; PG8_SCHED;
            } else {
            PG8_LDB(B0, 0, 0); PG8_SCHED; PG8_LDA(At, 0, 0); PG8_STAGE(PG8_SA(1, 1), a1 + hstep, voffA);
            PG8_WAIT_L(8); PG8_BAR; PG8_WAIT_L(0); PG8_MMA(0, 0, At, B0); PG8_BAR; PG8_SCHED;
            PG8_LDB(B1, 0, 1); PG8_STAGE(PG8_SB(0, 0), b2, voffB);
            PG8_BAR; PG8_WAIT_L(0); PG8_MMA(0, 1, At, B1); PG8_BAR;
            PG8_LDA(At, 0, 1); PG8_STAGE(PG8_SA(0, 0), a2, voffA);
            PG8_BAR; PG8_WAIT_L(0); PG8_MMA(1, 0, At, B0); PG8_BAR; PG8_SCHED;
            PG8_STAGE(PG8_SB(0, 1), b2 + hstep, voffB);
            PG8_WAIT_V(6); PG8_BAR; PG8_MMA(1, 1, At, B1); PG8_BAR;
            PG8_LDB(B0, 1, 0); PG8_SCHED; PG8_LDA(At, 1, 0); PG8_STAGE(PG8_SA(0, 1), a2 + hstep, voffA);
            PG8_WAIT_L(8); PG8_BAR; PG8_WAIT_L(0); PG8_MMA(0, 0, At, B0); PG8_BAR; PG8_SCHED;
            PG8_LDB(B1, 1, 1); PG8_STAGE(PG8_SB(1, 0), b3, voffB);
            PG8_BAR; PG8_WAIT_L(0); PG8_MMA(0, 1, At, B1); PG8_BAR;
            PG8_LDA(At, 1, 1); PG8_STAGE(PG8_SA(1, 0), a3, voffA);
            PG8_BAR; PG8_WAIT_L(0); PG8_MMA(1, 0, At, B0); PG8_BAR; PG8_SCHED;
            PG8_STAGE(PG8_SB(1, 1), b3 + hstep, voffB);
            PG8_WAIT_V(6); PG8_BAR; PG8_MMA(1, 1, At, B1); PG8_BAR;
            }
        }
        if constexpr (ALIGN_EPI) { if (wr == 0) PG8_BAR; }
        if constexpr (!Epi::AFTER_DRAIN) { E(acc, cur, wr, wc, fr, fq); S.done(cur); }
        if (!has_next) break;
#pragma unroll
        for (int a = 0; a < 2; ++a)
#pragma unroll
            for (int b = 0; b < 2; ++b)
#pragma unroll
                for (int m = 0; m < 4; ++m)
#pragma unroll
                    for (int n = 0; n < 2; ++n) acc[a][b][m][n] = (f32x4){0.f, 0.f, 0.f, 0.f};
        cur = nxt; cA = nA; cB = nB; ++ui;
        if constexpr (ALIGN_EPI) { if (wr == 1) PG8_BAR; }
    }
    PG8_WAIT_V(0);
    if constexpr (!ALIGN_EPI) { if (wr == 0) PG8_BAR; }
    PG8_BAR;
    if constexpr (Epi::AFTER_DRAIN) { E.fused(acc, cur, wr, wc, fr, fq, lds, wid, lane); S.done(cur); }
#undef PG8_SA
#undef PG8_SB
#undef PG8_STAGE
#undef PG8_LDA
#undef PG8_LDB
#undef PG8_MMA
#undef PG8_WAIT_V
#undef PG8_WAIT_L
#undef PG8_BAR
#undef PG8_SCHED
}
}

#ifndef PG8_SP2
#define PG8_SP2 true
#endif
#ifndef PG8_ALIGN
#define PG8_ALIGN true
#endif
#include <hip/hip_bf16.h>
#include <cmath>
namespace attn_body {
using bf16=__hip_bfloat16;
using bf16x8=__attribute__((ext_vector_type(8)))short;
using s16x4=__attribute__((ext_vector_type(4)))short;
using f32x16=__attribute__((ext_vector_type(16)))float;
using u32x4=__attribute__((ext_vector_type(4)))unsigned;
using f32x4_t=__attribute__((ext_vector_type(4)))float;
constexpr int BATCH=8,NHEAD=16,SEQ=4096,D=64,DM=NHEAD*D;
constexpr int NW=8,QBLK=32,QB=QBLK*NW,KVBLK=64,NQB=SEQ/QB;
constexpr int ATTN_PITCH=DM, ATTN_UNIT_ROWS=QB;
__device__ __forceinline__ int crow(int r,int hi){return (r&3)+8*(r>>2)+4*hi;}
#define SBAR() __builtin_amdgcn_sched_barrier(0)
__device__ __forceinline__ void cmask(f32x16&p0,f32x16&p1,int jb,int qrel,int hi){
  const float NEG=-INFINITY; int kb=64*jb+4*hi;
  #pragma unroll
  for(int r=0;r<16;++r){int kv=kb+(r&3)+8*(r>>2); if(kv>qrel)p0[r]=NEG; if(kv+32>qrel)p1[r]=NEG;}
}

constexpr int NSLOT=3, SLOTB=8192;
constexpr int LDS_K=0, LDS_V=NSLOT*SLOTB, LDS_WS=2*NSLOT*SLOTB, LDS_OST=LDS_WS+NW*64*4, LDS_F=LDS_OST+NW*4096, LDS_BYTES=LDS_F+NW*512;
constexpr float C2=0.125f*1.4426950408889634f;
__device__ __forceinline__ void glds16(const void*gsrc,unsigned lds_dst){unsigned keep;
  asm volatile("s_mov_b32 %0, m0\n\ts_mov_b32 m0, %2\n\ts_nop 0\n\tglobal_load_lds_dwordx4 %1, off\n\ts_mov_b32 m0, %0":"=&s"(keep):"v"(gsrc),"s"(lds_dst):"memory");}
__device__ __forceinline__ void glds16s(unsigned voff,const void*sbase,unsigned lds_dst){unsigned keep;
  asm volatile("s_nop 4\n\ts_mov_b32 %0, m0\n\ts_mov_b32 m0, %3\n\ts_nop 0\n\tglobal_load_lds_dwordx4 %1, %2\n\ts_mov_b32 m0, %0":"=&s"(keep):"v"(voff),"s"(sbase),"s"(lds_dst):"memory");}
__device__ __forceinline__ void glds4s(unsigned voff,const void*sbase,unsigned lds_dst){unsigned keep;
  asm volatile("s_nop 4\n\ts_mov_b32 %0, m0\n\ts_mov_b32 m0, %3\n\ts_nop 0\n\tglobal_load_lds_dword %1, %2\n\ts_mov_b32 m0, %0":"=&s"(keep):"v"(voff),"s"(sbase),"s"(lds_dst):"memory");}
__device__ __forceinline__ void glds4(const void*gsrc,unsigned lds_dst){unsigned keep;
  asm volatile("s_mov_b32 %0, m0\n\ts_mov_b32 m0, %2\n\ts_nop 0\n\tglobal_load_lds_dword %1, off\n\ts_mov_b32 m0, %0":"=&s"(keep):"v"(gsrc),"s"(lds_dst):"memory");}
__device__ __forceinline__ float max3f(float a,float b,float c){float r;asm("v_max3_f32 %0, %1, %2, %3":"=v"(r):"v"(a),"v"(b),"v"(c));return r;}
__device__ __forceinline__ float max2f(float a,float b){float r;asm("v_max_f32_e32 %0, %1, %2":"=v"(r):"v"(a),"v"(b));return r;}
__device__ __forceinline__ float fadd_s(float a,float b){float r;asm("v_add_f32_e32 %0, %1, %2":"=v"(r):"v"(a),"v"(b));return r;}
__device__ __forceinline__ float fsub_s(float a,float b){float r;asm("v_sub_f32_e32 %0, %1, %2":"=v"(r):"v"(a),"v"(b));return r;}
typedef float f32x2_t __attribute__((ext_vector_type(2))); typedef __bf16 bf16x2_t __attribute__((ext_vector_type(2)));
__device__ __forceinline__ unsigned cvtpk_s(float lo,float hi){f32x2_t v={lo,hi};bf16x2_t b=__builtin_convertvector(v,bf16x2_t);return __builtin_bit_cast(unsigned,b);}
#define WAIT_BAR(N) asm volatile("s_waitcnt vmcnt(" #N ") lgkmcnt(0)\n\ts_barrier":::"memory")

__device__ __forceinline__ void qkt(f32x16&p0,f32x16&p1,const char*Kslot,const bf16x8*qr,const f32x16&negm,int r32,int hi){
  const char*kb=Kslot+hi*1024+r32*16;
  #pragma unroll
  for(int d0=0;d0<4;++d0){
    const bf16x8 b0=*reinterpret_cast<const bf16x8*>(kb+d0*2048);
    const bf16x8 b1=*reinterpret_cast<const bf16x8*>(kb+d0*2048+512);
    if(d0==0){p0=__builtin_amdgcn_mfma_f32_32x32x16_bf16(b0,qr[0],negm,0,0,0);p1=__builtin_amdgcn_mfma_f32_32x32x16_bf16(b1,qr[0],negm,0,0,0);}
    else{p0=__builtin_amdgcn_mfma_f32_32x32x16_bf16(b0,qr[d0],p0,0,0,0);p1=__builtin_amdgcn_mfma_f32_32x32x16_bf16(b1,qr[d0],p1,0,0,0);}}
}
typedef __attribute__((address_space(3))) const char* lds_cptr;
typedef short v4i16_t __attribute__((ext_vector_type(4)));
__device__ __forceinline__ void kload8(bf16x8*kf,lds_cptr kp){
  kf[0]=*(const __attribute__((address_space(3))) bf16x8*)(kp);      kf[1]=*(const __attribute__((address_space(3))) bf16x8*)(kp+512);
  kf[2]=*(const __attribute__((address_space(3))) bf16x8*)(kp+2048); kf[3]=*(const __attribute__((address_space(3))) bf16x8*)(kp+2560);
  kf[4]=*(const __attribute__((address_space(3))) bf16x8*)(kp+4096); kf[5]=*(const __attribute__((address_space(3))) bf16x8*)(kp+4608);
  kf[6]=*(const __attribute__((address_space(3))) bf16x8*)(kp+6144); kf[7]=*(const __attribute__((address_space(3))) bf16x8*)(kp+6656);
}
__device__ __forceinline__ void kload2(bf16x8*kf,lds_cptr kp,int j){ kf[2*j]=*(const __attribute__((address_space(3))) bf16x8*)(kp+j*2048); kf[2*j+1]=*(const __attribute__((address_space(3))) bf16x8*)(kp+j*2048+512); }
__device__ __forceinline__ s16x4 vtr(lds_cptr p){ return __builtin_bit_cast(s16x4,__builtin_amdgcn_ds_read_tr16_b64_v4i16((__attribute__((address_space(3))) v4i16_t*)p)); }
__device__ __forceinline__ float rowmax(const f32x16&p0,const f32x16&p1){
  float a=max3f(p0[0],p0[1],p1[0]),b=max3f(p0[2],p0[3],p1[1]);a=max3f(a,p1[2],p1[3]);
  #pragma unroll
  for(int r=4;r<16;r+=4){a=max3f(a,p0[r],p0[r+1]);b=max3f(b,p0[r+2],p0[r+3]);a=max3f(a,p1[r],p1[r+1]);b=max3f(b,p1[r+2],p1[r+3]);}
  const float m=max2f(a,b);
  auto rr=__builtin_amdgcn_permlane32_swap(__float_as_uint(m),__float_as_uint(m),false,false);
  return max2f(__uint_as_float(rr[0]),__uint_as_float(rr[1]));
}
__device__ __forceinline__ void pv(f32x16*o,int vb,bf16x8 pa0,bf16x8 pa1,bf16x8 pa2,bf16x8 pa3){
  #pragma unroll
  for(int d0=0;d0<2;++d0){s16x4 lo[4],hi[4];
    #pragma unroll
    for(int ks=0;ks<4;++ks){
      asm volatile("ds_read_b64_tr_b16 %0,%1 offset:%c2":"=&v"(lo[ks]):"v"(vb),"i"(d0*4096+ks*1024):"memory");
      asm volatile("ds_read_b64_tr_b16 %0,%1 offset:%c2":"=&v"(hi[ks]):"v"(vb),"i"(d0*4096+ks*1024+512):"memory");}
    asm volatile("s_waitcnt lgkmcnt(0)":::"memory");SBAR();
    #define PK(k) (bf16x8){lo[k][0],lo[k][1],lo[k][2],lo[k][3],hi[k][0],hi[k][1],hi[k][2],hi[k][3]}
    o[d0]=__builtin_amdgcn_mfma_f32_32x32x16_bf16(pa0,PK(0),o[d0],0,0,0);
    o[d0]=__builtin_amdgcn_mfma_f32_32x32x16_bf16(pa1,PK(1),o[d0],0,0,0);
    o[d0]=__builtin_amdgcn_mfma_f32_32x32x16_bf16(pa2,PK(2),o[d0],0,0,0);
    o[d0]=__builtin_amdgcn_mfma_f32_32x32x16_bf16(pa3,PK(3),o[d0],0,0,0);
    #undef PK
  }
}

#ifndef ATTN_STORE16
#define ATTN_STORE16(p,v) (*(u32x4*)(p)=(v))
#endif
template<int THRL> __device__ __forceinline__ void attn_unit(int b,int h,int qb,const bf16*Q,const bf16*__restrict__ K,const bf16*__restrict__ V,bf16*O,const float*__restrict__ Fh,char*shm,const int tid){
  const int lane=tid&63,r32=lane&31,hi=lane>>5; const int wid=__builtin_amdgcn_readfirstlane(tid>>6);
  const long rowbase=(long)b*SEQ; const int q0=qb*QB;
  const bf16*Qw=Q+(rowbase+q0+wid*QBLK)*DM+h*D;
  const bf16*Kh=K+rowbase*DM+h*D,*Vh=V+rowbase*DM+h*D;
  const unsigned lds0=(unsigned)(uintptr_t)shm;
  float*wsf=(float*)(shm+LDS_WS)+wid*64;
  const unsigned koff=(unsigned)(lane*DM+wid*8)*2u;
  const unsigned voffv=(unsigned)((16*(wid&3)+(lane>>2))*DM+(wid>>2)*32+(lane&3)*8)*2u;
  const unsigned kdst=lds0+LDS_K+wid*1024, vdst=lds0+LDS_V+wid*1024;
  #define DMA_K(t,slot) glds16s(koff,Kh+(long)(t)*KVBLK*DM,(unsigned)__builtin_amdgcn_readfirstlane(kdst+(slot)))
  #define DMA_V(t,slot) glds16s(voffv,Vh+(long)(t)*KVBLK*DM,(unsigned)__builtin_amdgcn_readfirstlane(vdst+(slot)))
  const unsigned fdst=lds0+LDS_F+wid*512; const unsigned foff=(unsigned)lane*4u;
  #define DMA_F(t) glds4s(foff,Fh+(long)(t)*KVBLK,(unsigned)__builtin_amdgcn_readfirstlane(fdst+(((t)&1)*256)))
  typedef __attribute__((address_space(3))) const f32x4_t* lds_f4p; const lds_f4p fbp=(lds_f4p)((lds_cptr)shm+LDS_F+wid*512+hi*16);
  #define FBIAS(P0,P1,t) do{ const lds_f4p fp_=fbp+(((t)&1)*16); _Pragma("unroll") for(int g_=0;g_<4;++g_){ { const f32x4_t fa_=fp_[2*g_]; _Pragma("unroll") for(int i_=0;i_<4;++i_) P0[4*g_+i_]=(P0[4*g_+i_]-mhat)-fa_[i_]; } SBAR(); \
      { const f32x4_t fb_=fp_[8+2*g_]; _Pragma("unroll") for(int i_=0;i_<4;++i_) P1[4*g_+i_]=(P1[4*g_+i_]-mhat)-fb_[i_]; } SBAR(); } }while(0)
  const int vb0=(int)(lds0+LDS_V)+((lane>>4)&1)*32+(lane&3)*8+(4*hi+((lane&15)>>2))*64;
  const char*Kbase=shm+LDS_K; bf16x8 kf[8];
  const lds_cptr shm3=(lds_cptr)shm; const lds_cptr kp0=shm3+LDS_K+hi*1024+r32*16; const lds_cptr vp0=shm3+LDS_V+((lane>>4)&1)*32+(lane&3)*8+(4*hi+((lane&15)>>2))*64;
  const int NT=(q0+QB)/KVBLK;
  DMA_F(0);DMA_F(1);DMA_K(0,0);DMA_V(0,0);DMA_K(1,SLOTB);
  bf16x8 qr[4];
  #pragma unroll
  for(int d0=0;d0<4;++d0)qr[d0]=*reinterpret_cast<const bf16x8*>(&Qw[(long)r32*DM+d0*16+hi*8]);
  const float fq0=Fh[q0+wid*QBLK+r32];
  float mhat=-fq0,l_reg=0.f;f32x16 o[2];o[0]=f32x16{};o[1]=f32x16{};const f32x16 negm=f32x16{};
  const int qrel=wid*QBLK+r32;
  #define CMASK(P0,P1,t) do{int jb_=(t)-(NT-4); if(jb_>=0)cmask(P0,P1,jb_,qrel,hi);}while(0)
  bool resc=false;
  #define START(P0,P1) do{ const float rm=rowmax(P0,P1); resc=false; \
    { const float dl=rm; mhat=fadd_s(mhat,dl); \
      _Pragma("unroll") for(int r=0;r<16;++r){P0[r]=fsub_s(P0[r],dl);P1[r]=fsub_s(P1[r],dl);} \
      } \
    _Pragma("unroll") for(int r=0;r<16;++r)P0[r]=__builtin_amdgcn_exp2f(P0[r]); }while(0)
  #define RESC() do{ if(resc){ asm volatile("s_waitcnt lgkmcnt(0)":::"memory"); \
      _Pragma("unroll") for(int d_=0;d_<2;++d_) _Pragma("unroll") for(int r=0;r<16;++r)o[d_][r]*=wsf[crow(r,hi)]; } }while(0)
  f32x16 pA0,pA1,pB0,pB1;
  int sl_prev=0,sl_cur=0,sl_next=SLOTB;
  #define ROT() do{sl_prev=sl_cur;sl_cur=sl_next;sl_next=(sl_next==(NSLOT-1)*SLOTB)?0:sl_next+SLOTB;}while(0)
  DMA_K(2,2*SLOTB);
  WAIT_BAR(3);
  qkt(pA0,pA1,Kbase,qr,negm,r32,hi);asm volatile("s_nop 15\n\ts_nop 7":"+v"(pA0),"+v"(pA1));FBIAS(pA0,pA1,0);CMASK(pA0,pA1,0);
  START(pA0,pA1);
  _Pragma("unroll") for(int r=0;r<16;++r)pA1[r]=__builtin_amdgcn_exp2f(pA1[r]);
  WAIT_BAR(0);
  DMA_K(3,0);DMA_V(1,SLOTB);
  ROT();
  kload8(kf,kp0+sl_cur);
  WAIT_BAR(2);
  s16x4 vlo[8],vhi[8]; u32x4 pw0,pw1,pw2,pw3;
  #define PKW(P,B) cvtpk_s(P[B],P[B+1])
  #define PAF(k) __builtin_bit_cast(bf16x8,pw##k)
  #define VFR(i) (bf16x8){vlo[i][0],vlo[i][1],vlo[i][2],vlo[i][3],vhi[i][0],vhi[i][1],vhi[i][2],vhi[i][3]}
  #define PIN(x) asm volatile("":"+v"(x))
  #define MX3(a,b,c) __builtin_fmaxf(__builtin_fmaxf((a),(b)),(c))
  #define GAPA(MF,A0,A1,A2,A3,W0,W1,PW) do{ MF; sacc+=A0; sacc+=A1; sacc+=A2; sacc+=A3; PIN(sacc); W0; W1; PIN(PW); SBAR(); }while(0)
  #define EX(v) __builtin_amdgcn_exp2f(v)
  #define GAPB(MF,X,B) do{ MF; X[B]=EX(X[B]); X[B+1]=EX(X[B+1]); X[B+2]=EX(X[B+2]); X[B+3]=EX(X[B+3]); PIN(X); SBAR(); }while(0)
  #define VRD(i) do{ vlo[i]=vtr(vp_+(((i)>>2)*4096+((i)&3)*1024)); vhi[i]=vtr(vp_+(((i)>>2)*4096+((i)&3)*1024+512)); }while(0)
  #define KRD(G,j) do{ if(G){ kload2(kf,kp0+sl_next,j); SBAR(); } }while(0)
  #define STEP(C0,C1,P0,P1,t,GK,GV,GL) do{ SBAR(); if(GV){DMA_F((t)+1);} \
    const lds_cptr vp_=vp0+sl_prev; \
    float sacc=(P0[0]+P0[1]); \
    GAPA(C0=__builtin_amdgcn_mfma_f32_32x32x16_bf16(kf[0],qr[0],negm,0,0,0), P0[2],P0[3],P0[4],P0[5],     pw0[0]=PKW(P0,0), pw0[1]=PKW(P0,2), pw0); \
    GAPA(C1=__builtin_amdgcn_mfma_f32_32x32x16_bf16(kf[1],qr[0],negm,0,0,0), P0[6],P0[7],P0[8],P0[9],     pw0[2]=PKW(P0,4), pw0[3]=PKW(P0,6), pw0); \
    GAPA(C0=__builtin_amdgcn_mfma_f32_32x32x16_bf16(kf[2],qr[1],C0,0,0,0),   P0[10],P0[11],P0[12],P0[13], pw1[0]=PKW(P0,8), pw1[1]=PKW(P0,10), pw1); \
    GAPA(C1=__builtin_amdgcn_mfma_f32_32x32x16_bf16(kf[3],qr[1],C1,0,0,0),   P0[14],P0[15],P1[0],P1[1],   pw1[2]=PKW(P0,12),pw1[3]=PKW(P0,14), pw1); \
    GAPA(C0=__builtin_amdgcn_mfma_f32_32x32x16_bf16(kf[4],qr[2],C0,0,0,0),   P1[2],P1[3],P1[4],P1[5],     pw2[0]=PKW(P1,0), pw2[1]=PKW(P1,2), pw2); \
    GAPA(C1=__builtin_amdgcn_mfma_f32_32x32x16_bf16(kf[5],qr[2],C1,0,0,0),   P1[6],P1[7],P1[8],P1[9],     pw2[2]=PKW(P1,4), pw2[3]=PKW(P1,6), pw2); \
    GAPA(C0=__builtin_amdgcn_mfma_f32_32x32x16_bf16(kf[6],qr[3],C0,0,0,0),   P1[10],P1[11],P1[12],P1[13], pw3[0]=PKW(P1,8), pw3[1]=PKW(P1,10), pw3); \
    GAPA(C1=__builtin_amdgcn_mfma_f32_32x32x16_bf16(kf[7],qr[3],C1,0,0,0),   P1[14],P1[15],0.f,0.f,       pw3[2]=PKW(P1,12),pw3[3]=PKW(P1,14), pw3); \
    l_reg+=sacc; \
    if(GK){DMA_K((t)+3,sl_cur);} if(GV){DMA_V((t)+1,sl_next);} \
    FBIAS(C0,C1,t); CMASK(C0,C1,t); \
    { float a=MX3(C0[0],C0[1],C1[0]),b=MX3(C0[2],C0[3],C1[1]); a=MX3(a,C1[2],C1[3]); \
      _Pragma("unroll") for(int r=4;r<16;r+=4){a=MX3(a,C0[r],C0[r+1]);b=MX3(b,C0[r+2],C0[r+3]);a=MX3(a,C1[r],C1[r+1]);b=MX3(b,C1[r+2],C1[r+3]);} \
      float rm=__builtin_fmaxf(a,b); { auto rr=__builtin_amdgcn_permlane32_swap(__float_as_uint(rm),__float_as_uint(rm),false,false); rm=__builtin_fmaxf(__uint_as_float(rr[0]),__uint_as_float(rr[1])); } \
      resc=false; \
      if(__builtin_expect(__any(rm>(float)THRL),0)){ const float dl=__builtin_fmaxf(rm,0.f); mhat+=dl; \
        _Pragma("unroll") for(int r=0;r<16;++r){C0[r]-=dl;C1[r]-=dl;} \
        const float f=__builtin_amdgcn_exp2f(-dl); l_reg*=f; if(hi==0)wsf[r32]=f; resc=true; } } \
    SBAR(); \
    VRD(0); VRD(4); SBAR(); VRD(1); SBAR(); GAPB(o[0]=__builtin_amdgcn_mfma_f32_32x32x16_bf16(PAF(0),VFR(0),o[0],0,0,0), C0,0); \
    VRD(5); SBAR(); GAPB(o[1]=__builtin_amdgcn_mfma_f32_32x32x16_bf16(PAF(0),VFR(4),o[1],0,0,0), C0,4); \
    KRD(GL,0); VRD(2); SBAR(); GAPB(o[0]=__builtin_amdgcn_mfma_f32_32x32x16_bf16(PAF(1),VFR(1),o[0],0,0,0), C0,8); \
    KRD(GL,1); VRD(6); SBAR(); GAPB(o[1]=__builtin_amdgcn_mfma_f32_32x32x16_bf16(PAF(1),VFR(5),o[1],0,0,0), C0,12); \
    KRD(GL,2); VRD(3); SBAR(); GAPB(o[0]=__builtin_amdgcn_mfma_f32_32x32x16_bf16(PAF(2),VFR(2),o[0],0,0,0), C1,0); \
    KRD(GL,3); VRD(7); SBAR(); GAPB(o[1]=__builtin_amdgcn_mfma_f32_32x32x16_bf16(PAF(2),VFR(6),o[1],0,0,0), C1,4); \
    GAPB(o[0]=__builtin_amdgcn_mfma_f32_32x32x16_bf16(PAF(3),VFR(3),o[0],0,0,0), C1,8); \
    GAPB(o[1]=__builtin_amdgcn_mfma_f32_32x32x16_bf16(PAF(3),VFR(7),o[1],0,0,0), C1,12); \
    }while(0)
  int t=1;
  #undef CMASK
  #define CMASK(P0,P1,t) do{}while(0)
  for(;t+5<NT;t+=2){
    STEP(pB0,pB1,pA0,pA1,t,true,true,true);     WAIT_BAR(2); RESC(); ROT();
    STEP(pA0,pA1,pB0,pB1,t+1,true,true,true);   WAIT_BAR(2); RESC(); ROT();
  }
  #undef CMASK
  #define CMASK(P0,P1,t) do{int jb_=(t)-(NT-4); if(jb_>=0)cmask(P0,P1,jb_,qrel,hi);}while(0)
  #define ENDW(tt) do{ if((tt)+3<NT){WAIT_BAR(2);} else if((tt)+2<NT){WAIT_BAR(1);} else {WAIT_BAR(0);} }while(0)
  for(;t+1<NT;t+=2){
    STEP(pB0,pB1,pA0,pA1,t,(t+3<NT),(t+1<NT),(t+1<NT));       ENDW(t);   RESC(); ROT();
    STEP(pA0,pA1,pB0,pB1,t+1,(t+4<NT),(t+2<NT),(t+2<NT));     ENDW(t+1); RESC(); ROT();
  }
  STEP(pB0,pB1,pA0,pA1,NT-1,false,false,false); RESC();
  { float sacc=pB0[0]+pB0[1]; _Pragma("unroll") for(int r=2;r<16;++r)sacc+=pB0[r]; _Pragma("unroll") for(int r=0;r<16;++r)sacc+=pB1[r]; l_reg+=sacc;
    pw0=(u32x4){PKW(pB0,0),PKW(pB0,2),PKW(pB0,4),PKW(pB0,6)};pw1=(u32x4){PKW(pB0,8),PKW(pB0,10),PKW(pB0,12),PKW(pB0,14)};pw2=(u32x4){PKW(pB1,0),PKW(pB1,2),PKW(pB1,4),PKW(pB1,6)};pw3=(u32x4){PKW(pB1,8),PKW(pB1,10),PKW(pB1,12),PKW(pB1,14)};
    SBAR(); pv(o,vb0+sl_cur,PAF(0),PAF(1),PAF(2),PAF(3)); }
  #undef PKW
  #undef PAF
  #undef VFR
  #undef PIN
  #undef MX3
  #undef GAPA
  #undef GAPB
  #undef EX
  #undef VRD
  #undef KRD
  #undef STEP
  #undef ENDW
  {auto rr=__builtin_amdgcn_permlane32_swap(__float_as_uint(l_reg),__float_as_uint(l_reg),false,false);l_reg=__uint_as_float(rr[0])+__uint_as_float(rr[1]);}
  if(hi==0)wsf[32+r32]=l_reg;asm volatile("s_waitcnt lgkmcnt(0)":::"memory");
  float rli[16];
  #pragma unroll
  for(int r=0;r<16;++r)rli[r]=__builtin_amdgcn_rcpf(wsf[32+crow(r,hi)]);
  bf16*Ow=O+(rowbase+q0+wid*QBLK)*DM+h*D;
  { bf16*stg=(bf16*)(shm+LDS_OST)+wid*2048;
    #pragma unroll
    for(int r=0;r<16;++r){const int orow=crow(r,hi);
      #pragma unroll
      for(int d0=0;d0<2;++d0)stg[orow*64+d0*32+r32]=__float2bfloat16(o[d0][r]*rli[r]);}
    asm volatile("s_waitcnt lgkmcnt(0)":::"memory");
    #pragma unroll
    for(int i=0;i<4;++i){const int row=i*8+(lane>>3),ch=lane&7; const u32x4 v=*(const u32x4*)(stg+row*64+ch*8); ATTN_STORE16(Ow+(long)row*DM+ch*8,v);} }
  asm volatile("s_waitcnt lgkmcnt(0)\n\ts_barrier":::"memory");
  #undef DMA_K
  #undef DMA_V
  #undef DMA_F
  #undef FBIAS
  #undef CMASK
  #undef START
  #undef RESC
  #undef ROT
}
constexpr int ATTN_LDS_BYTES=LDS_BYTES;
struct AttnTensors { const bf16* Q; const bf16* K; const bf16* V; bf16* O; const float* F; };
struct AttnUnit { int bh; int qb; };
struct StaticOrder {
  int vcu,G;
  __device__ __forceinline__ explicit StaticOrder(int grid,int v):vcu(v),G(grid){}
  __device__ __forceinline__ bool next(int i,AttnUnit&u)const{
    if(G==256){ if(i>=8)return false; const int s=(vcu&1)*4+(i>>1); u.bh=vcu>>1; u.qb=(i&1)?15-s:s; return true; }
    const int L=i*G+vcu; if(L>=BATCH*NHEAD*NQB)return false; u.bh=L/NQB; u.qb=L%NQB; return true; }
  __device__ __forceinline__ void a_ready(const AttnUnit&)const{}
  __device__ __forceinline__ void done(const AttnUnit&)const{}
};
template<class Sched,int THRL=8> __device__ __forceinline__ void attn_phase(char*lds,const AttnTensors&T,const Sched&S,const int tid){
  AttnUnit u;
  for(int i=0;S.next(i,u);++i){ S.a_ready(u); attn_unit<THRL>(u.bh/NHEAD,u.bh%NHEAD,u.qb,T.Q,T.K,T.V,T.O,T.F+(long)u.bh*SEQ,lds,tid); S.done(u); }
}
#undef SBAR
#undef WAIT_BAR
}
#define GAS __attribute__((address_space(1)))
#define LAS __attribute__((address_space(3)))
typedef unsigned short bf16;
typedef unsigned v4u __attribute__((ext_vector_type(4)));
typedef float f32x4 __attribute__((ext_vector_type(4)));
typedef short bf16x8 __attribute__((ext_vector_type(8)));
typedef GAS unsigned gu32;
typedef GAS unsigned long long gu64;
#define RLX_AGENT __ATOMIC_RELAXED, __HIP_MEMORY_SCOPE_AGENT
#define LDS_WAIT() asm volatile("s_waitcnt lgkmcnt(0)" ::: "memory")
#define VM_WAIT() asm volatile("s_waitcnt vmcnt(0)" ::: "memory")
__device__ __forceinline__ unsigned long long rt() { return __builtin_amdgcn_s_memrealtime(); }
__device__ __forceinline__ unsigned f2bf(float f) { unsigned u = __builtin_bit_cast(unsigned, f); return (u + 0x7fffu + ((u >> 16) & 1u)) >> 16; }
__device__ __forceinline__ unsigned pk2(float lo, float hi) { return f2bf(lo) | (f2bf(hi) << 16); }

#define XB_TMO      128
#define XB_XCNT(j)  (256  + 64 * (j))
#define XB_XSUB(j)  (1280 + 64 * (j))
#define XB_XGEN(j)  (2304 + 64 * (j))
#define XB_TOP      3328
#define XB_TOPGEN   3392
#define XCD_BAR_WORDS 3456
#define XB_SPIN_CAP (1u << 18)

__device__ __forceinline__ unsigned xb_ld(unsigned* p)              { return __hip_atomic_load(p, __ATOMIC_RELAXED, __HIP_MEMORY_SCOPE_AGENT); }
__device__ __forceinline__ unsigned xb_add(unsigned* p, unsigned v) { return __hip_atomic_fetch_add(p, v, __ATOMIC_RELAXED, __HIP_MEMORY_SCOPE_AGENT); }
__device__ __forceinline__ unsigned xb_xcc_id() { return (unsigned)__builtin_amdgcn_s_getreg((3 << 11) | 20) & 0xFu; }
#define XB_SPIN(cond, bar) do { unsigned _sp = 0; while (cond) { __builtin_amdgcn_s_sleep(1); \
    if ((++_sp & 255u) == 0u) { if (xb_ld(&(bar)[XB_TMO])) break; if (_sp > XB_SPIN_CAP) { atomicAdd(&(bar)[XB_TMO], 1u); break; } } } } while (0)

struct XcdBarrier {
    unsigned* bar; unsigned x;
    volatile LAS unsigned* st;
};

__device__ __forceinline__ XcdBarrier xcd_barrier_post(unsigned* bar, volatile LAS unsigned* st) {
    XcdBarrier b; b.bar = bar; b.x = xb_xcc_id(); b.st = st;
    if (threadIdx.x == 0) (void)xb_add(&bar[XB_XCNT(b.x)], 1u);
    return b;
}
__device__ __forceinline__ void xcd_barrier_complete(unsigned* bar, unsigned x, unsigned& nloc, unsigned& nx) {
    const unsigned G = gridDim.x * gridDim.y * gridDim.z;
    unsigned sum, cnt, mine, sp = 0u;
    for (;;) {
        sum = 0u; cnt = 0u; mine = 0u;
#pragma unroll
        for (unsigned j = 0; j < 16; ++j) { const unsigned c = xb_ld(&bar[XB_XCNT(j)]); sum += c; cnt += (c > 0u) ? 1u : 0u; mine = (j == x) ? c : mine; }
        if (sum == G) break;
        __builtin_amdgcn_s_sleep(1);
        if ((++sp & 255u) == 0u) { if (xb_ld(&bar[XB_TMO])) break; if (sp > XB_SPIN_CAP) { atomicAdd(&bar[XB_TMO], 1u); break; } }
    }
    nloc = mine > 0u ? mine : 1u; nx = cnt > 0u ? cnt : 1u;
}

__device__ __forceinline__ void xcd_barrier(const XcdBarrier& b) {
    asm volatile("s_waitcnt vmcnt(0)" ::: "memory");
    __syncthreads();
    if (threadIdx.x == 0) {
        unsigned* bar = b.bar;
        __builtin_amdgcn_s_waitcnt(0);
        unsigned nloc = b.st[0], nx = b.st[1];
        if (nloc == 0u) { xcd_barrier_complete(bar, b.x, nloc, nx); b.st[0] = nloc; b.st[1] = nx; }
        const unsigned old = xb_add(&bar[XB_XSUB(b.x)], 1u);
        const unsigned gen = old / nloc;
        if (old + 1u == (gen + 1u) * nloc) {
            __builtin_amdgcn_fence(__ATOMIC_RELEASE, "agent");
            asm volatile("s_waitcnt vmcnt(0)" ::: "memory");
            const unsigned og = xb_add(&bar[XB_TOP], 1u);
            const unsigned tg = og / nx;
            if (og + 1u == (tg + 1u) * nx) xb_add(&bar[XB_TOPGEN], 1u);
            else XB_SPIN(xb_ld(&bar[XB_TOPGEN]) == tg, bar);
            __builtin_amdgcn_fence(__ATOMIC_ACQUIRE, "agent");
            xb_add(&bar[XB_XGEN(b.x)], 1u);
            asm volatile("s_waitcnt vmcnt(0)" ::: "memory");
        } else {
            XB_SPIN(xb_ld(&bar[XB_XGEN(b.x)]) == gen, bar);
            __builtin_amdgcn_fence(__ATOMIC_ACQUIRE, "agent");
            asm volatile("s_waitcnt vmcnt(0)" ::: "memory");
        }
    }
    __syncthreads();
}


constexpr int NWAVES = 8;
constexpr int BATCH = 8, SEQ = 4096, D = 1024, NTOK = BATCH * SEQ;
constexpr int DEPTH = 4, D_IN = 9232, D_INP = 9472;
constexpr int DFF = 2816, NEXP = 8, DFE = 3584, NADA = 6, ADAW = NADA * D;
constexpr int NQ = 128;
constexpr float EPS = 1e-6f;
constexpr float LOG2E = 1.4426950408889634f;
constexpr int MOE_TILES_MAX = 264;

constexpr size_t MiB = 1u << 20;
constexpr size_t WS_CTL = 0, CTL_ZERO_BYTES = 1 * MiB;
constexpr size_t WS_ADAP = 1 * MiB;
constexpr size_t WS_ADA = 4 * MiB;
constexpr size_t WS_LB = 4 * MiB + 800 * 1024;
constexpr size_t WS_LF = 5 * MiB;
constexpr size_t WS_F = 7 * MiB;
constexpr size_t WS_DL = 9 * MiB;
constexpr size_t WS_DSC = 13 * MiB;
constexpr size_t WS_ROUTE = 13 * MiB + 512 * 1024;
constexpr size_t WS_U = 16 * MiB;
constexpr size_t WS_WIN = 80 * MiB;
constexpr size_t WS_WOUT = 154 * MiB;
constexpr size_t WS_WGU = 162 * MiB;
constexpr size_t WS_WDN = 184 * MiB;
constexpr size_t WS_XN = 196 * MiB;
constexpr size_t WS_ACT = 260 * MiB;
constexpr size_t ACTB = 64 * MiB;
constexpr size_t WS_INTER_D = WS_ACT;
constexpr size_t WS_INTER_M = 196 * MiB;
constexpr size_t WS_WMGU = 664 * MiB;
constexpr size_t WS_WMDN = 776 * MiB;
constexpr size_t WS_HS = 832 * MiB;
constexpr size_t WS_END = 964 * MiB;
static_assert(WS_INTER_M + (size_t)MOE_TILES_MAX * 256 * DFE * 2 <= WS_WMGU && WS_HS + (size_t)MOE_TILES_MAX * 256 * D * 2 <= WS_END && WS_ACT + 11 * ACTB == WS_END, "d_ws map");
constexpr int CW_TMO = 0, CW_CODE = 1;
constexpr int CW_BAR = 4096;
constexpr int CW_CNT = 16384;

constexpr int RING_OFF = 0, RING_BYTES = 131072;
constexpr int LDSCTL_OFF = RING_BYTES, MISC_OFF = LDSCTL_OFF + 320, PTAB_OFF = LDSCTL_OFF + 1024;
constexpr int LDS_BYTES = 147456;
static_assert(MISC_OFF + 128 <= LDS_BYTES, "LDS map");

struct Frame {
    LAS unsigned char* lds;
    volatile LAS unsigned* MISC;
    gu32* ctl;
    int tid, lane, wave, vcu, G;
    unsigned char* ws;
};

__device__ __forceinline__ float shfl_idx(float v, int src_lane) { return __int_as_float(__builtin_amdgcn_ds_bpermute(src_lane << 2, __float_as_int(v))); }
__device__ __forceinline__ float wave_sum(float v, int lane) {
#pragma unroll
    for (int o = 1; o < 64; o <<= 1) v += shfl_idx(v, lane ^ o);
    return v;
}
__device__ __forceinline__ float bf2f(unsigned short h) { return __uint_as_float((unsigned)h << 16); }
__device__ __forceinline__ float bflo(unsigned w) { return __uint_as_float(w << 16); }
__device__ __forceinline__ float bfhi(unsigned w) { return __uint_as_float(w & 0xffff0000u); }
__device__ __forceinline__ float sigmoidf_(float v) { return 1.0f / (1.0f + __expf(-v)); }

__device__ __forceinline__ void tr_item(const float* W, int ldn, int s0, int nvalid, int k0, bf16* WT, int K, int d0, LAS float* scr, int lane) {
#pragma unroll 8
    for (int i = 0; i < 32; ++i) { const int kk = 2 * i + (lane >> 5), n = lane & 31; scr[kk * 33 + n] = (n < nvalid) ? W[(size_t)(k0 + kk) * ldn + s0 + n] : 0.f; }
    LDS_WAIT(); asm volatile("" ::: "memory");
    const int c = lane & 7;
#pragma unroll
    for (int j = 0; j < 4; ++j) { const int n = (lane >> 3) + 8 * j; const LAS float* s = scr + (8 * c) * 33 + n;
        v4u o; o.x = pk2(s[0 * 33], s[1 * 33]); o.y = pk2(s[2 * 33], s[3 * 33]); o.z = pk2(s[4 * 33], s[5 * 33]); o.w = pk2(s[6 * 33], s[7 * 33]);
        *(GAS v4u*)(WT + (size_t)(d0 + n) * K + k0 + 8 * c) = o; }
    LDS_WAIT(); asm volatile("" ::: "memory");
}
__device__ __forceinline__ void tr_gateup(const float* Wg, const float* Wu, int dff, int r, bf16* WT, LAS float* scr, int lane) {
    const int nblk = 2 * dff / 32, kb = r / nblk, db = r % nblk, p = db >> 3, q = db & 7;
    tr_item(q < 4 ? Wg : Wu, dff, 128 * p + 32 * (q & 3), 32, 64 * kb, WT, D, 32 * db, scr, lane);
}
__device__ __forceinline__ void tr_plain(const float* W, int K, int N, int r, bf16* WT, LAS float* scr, int lane) {
    const int nblk = N / 32, kb = r / nblk, db = r % nblk;
    tr_item(W, N, 32 * db, 32, 64 * kb, WT, K, 32 * db, scr, lane);
}

enum InIdx { IN_X = 0, IN_C, IN_WADA, IN_BADA, IN_NMIX, IN_NFFN, IN_WIN, IN_QG, IN_KG, IN_FB, IN_LB, IN_OG, IN_WOUT, IN_WR, IN_BR, IN_DG, IN_DU, IN_DD, IN_MG, IN_MU, IN_MD, IN_OUT };
__device__ __forceinline__ float* gptr(const Frame& F, int k) {
    const LAS unsigned* t = (const LAS unsigned*)(F.lds + PTAB_OFF) + 2 * k; const unsigned lo = __builtin_amdgcn_readfirstlane(t[0]), hi = __builtin_amdgcn_readfirstlane(t[1]);
    return (float*)(((unsigned long long)hi << 32) | lo); }

__device__ __forceinline__ void p0_prologue(Frame& F) {
    LAS float* scr = (LAS float*)(F.lds + RING_OFF + F.wave * 16384);
    const int gw = F.vcu * NWAVES + F.wave, NGW = F.G * NWAVES;
    {
        LAS float* cs = (LAS float*)(F.lds + RING_OFF + 8 * 16384 - 32768);
        const float* cp_ = gptr(F, IN_C);
        for (int i = F.tid; i < 8192; i += NWAVES * 64) { const int b = i >> 10, k = i & 1023; const float v = cp_[i]; cs[k * 8 + b] = v * sigmoidf_(v); }
        __syncthreads();
        float* P = (float*)(F.ws + WS_ADAP);
        for (int it = gw; it < 4 * 24 * 4; it += NGW) {
            const int l = it / 96, r = it % 96, nb = r >> 2, ks = r & 3;
            f32x4 acc[8];
#pragma unroll
            for (int b = 0; b < 8; ++b) acc[b] = (f32x4){0.f, 0.f, 0.f, 0.f};
            const float* wp = gptr(F, IN_WADA) + ((size_t)l * D + ks * 256) * ADAW + nb * 256 + F.lane * 4;
#pragma unroll 8
            for (int k = 0; k < 256; ++k) { const f32x4 w = *(const f32x4*)(wp + (size_t)k * ADAW);
                const f32x4 c0 = *(const LAS f32x4*)(cs + (ks * 256 + k) * 8), c1 = *(const LAS f32x4*)(cs + (ks * 256 + k) * 8 + 4);
                acc[0] += c0[0] * w; acc[1] += c0[1] * w; acc[2] += c0[2] * w; acc[3] += c0[3] * w; acc[4] += c1[0] * w; acc[5] += c1[1] * w; acc[6] += c1[2] * w; acc[7] += c1[3] * w; }
#pragma unroll
            for (int b = 0; b < 8; ++b) *(f32x4*)(P + ((size_t)(ks * 4 + l) * 8 + b) * ADAW + nb * 256 + F.lane * 4) = acc[b];
        }
        __syncthreads();
    }
    for (int c = gw * 64 + F.lane; c < 1024; c += NGW * 64) {
        const float* lbi = gptr(F, IN_LB); const float a0 = lbi[c], a1 = lbi[1024 + c], a2 = lbi[2048 + c], a3 = lbi[3072 + c];
        const float mx = fmaxf(fmaxf(a0, a1), fmaxf(a2, a3));
        const float e0 = expf(a0 - mx), e1 = expf(a1 - mx), e2 = expf(a2 - mx), e3 = expf(a3 - mx), inv = 1.0f / (e0 + e1 + e2 + e3);
        float* lb = (float*)(F.ws + WS_LB);
        lb[c] = 0.f; lb[1024 + c] = e1 * inv; lb[2048 + c] = (e1 + e2) * inv; lb[3072 + c] = (e1 + e2 + e3) * inv;
    }
    constexpr int I_IN = 16 * (D_INP / 32), I_OUT = 16 * 32, I_GU = 16 * (2 * DFF / 32), I_DN = (DFF / 64) * 32;
    constexpr int NIT = 4 * (I_IN + I_OUT) + 2 * (I_GU + I_DN);
    for (int it = gw; it < NIT; it += NGW) {
        int r = it;
        if (r < 4 * I_IN) { const int l = r / I_IN; r -= l * I_IN; const int kb = r / (D_INP / 32), db = r % (D_INP / 32);
            int s0, nv; if (db < 96) { s0 = 32 * db; nv = 32; } else if (db < 288) { s0 = 32 * db + 16; nv = 32; } else if (db == 288) { s0 = 3072; nv = 16; } else { s0 = 0; nv = 0; }
            tr_item(gptr(F, IN_WIN) + (size_t)l * D * D_IN, D_IN, s0, nv, 64 * kb, (bf16*)(F.ws + WS_WIN) + (size_t)l * D_INP * D, D, 32 * db, scr, F.lane); continue; }
        r -= 4 * I_IN;
        if (r < 4 * I_OUT) { const int l = r / I_OUT; r -= l * I_OUT; tr_plain(gptr(F, IN_WOUT) + (size_t)l * D * D, D, D, r, (bf16*)(F.ws + WS_WOUT) + (size_t)l * D * D, scr, F.lane); continue; }
        r -= 4 * I_OUT;
        if (r < 2 * I_GU) { const int i = r / I_GU; r -= i * I_GU; tr_gateup(gptr(F, IN_DG) + (size_t)i * D * DFF, gptr(F, IN_DU) + (size_t)i * D * DFF, DFF, r, (bf16*)(F.ws + WS_WGU) + (size_t)i * 2 * DFF * D, scr, F.lane); continue; }
        r -= 2 * I_GU;
        { const int i = r / I_DN; r -= i * I_DN; tr_plain(gptr(F, IN_DD) + (size_t)i * DFF * D, DFF, D, r, (bf16*)(F.ws + WS_WDN) + (size_t)i * D * DFF, scr, F.lane); }
    }
}
__device__ __forceinline__ void moe_weights(Frame& F, int i) {
    LAS float* scr = (LAS float*)(F.lds + RING_OFF + F.wave * 16384);
    const int gw = F.vcu * NWAVES + F.wave, NGW = F.G * NWAVES;
    constexpr int I_GU = 16 * (2 * DFE / 32), I_DN = (DFE / 64) * 32, PER = I_GU + I_DN;
    for (int it = gw; it < NEXP * PER; it += NGW) {
        const int e = it / PER; int r = it % PER; const size_t we = (size_t)(i * NEXP + e) * D * DFE;
        if (r < I_GU) tr_gateup(gptr(F, IN_MG) + we, gptr(F, IN_MU) + we, DFE, r, (bf16*)(F.ws + WS_WMGU) + (size_t)e * 2 * DFE * D, scr, F.lane);
        else tr_plain(gptr(F, IN_MD) + we, DFE, D, r - I_GU, (bf16*)(F.ws + WS_WMDN) + (size_t)e * D * DFE, scr, F.lane);
    }
}
__device__ __forceinline__ void ada_final(Frame& F) {
    const float* P = (const float*)(F.ws + WS_ADAP); float* A = (float*)(F.ws + WS_ADA);
    const int gt = F.vcu * NWAVES * 64 + F.tid, NT = F.G * NWAVES * 64;
    const float* bad = gptr(F, IN_BADA);
    for (int i = gt; i < 4 * 8 * ADAW; i += NT) { const int l = i / (8 * ADAW), n = i % ADAW;
        A[i] = bad[l * ADAW + n] + ((P[i] + P[(size_t)4 * 8 * ADAW + i]) + (P[(size_t)2 * 4 * 8 * ADAW + i] + P[(size_t)3 * 4 * 8 * ADAW + i])); }
}

__device__ __forceinline__ void moe_offsets(const gu32* cnt, int (&off)[9], int (&n)[8]) {
    int o = 0;
#pragma unroll
    for (int e = 0; e < 8; ++e) { n[e] = (int)__hip_atomic_load(cnt + e * 64, RLX_AGENT); off[e] = o; o += (n[e] + 255) & ~255; }
    off[8] = o;
}

__device__ __forceinline__ void row_phase(Frame& F, bool first, bool do_comb, int lprev, int do_norm, int l, bool do_route) {
    float* const out = gptr(F, IN_OUT); const float* const src = first ? (const float*)gptr(F, IN_X) : (const float*)out;
    const float* const ada = (const float*)(F.ws + WS_ADA);
    const int moe_prev = lprev >> 1, moe_i = l >> 1;
    const float* const g2prev = ada + (size_t)lprev * 8 * ADAW + 5 * D;
    const float* const gain = (do_norm == 2 ? gptr(F, IN_NFFN) : gptr(F, IN_NMIX)) + l * D;
    const float* const sc = ada + (size_t)l * 8 * ADAW + (do_norm == 2 ? 4 : 1) * D; const float* const sh = ada + (size_t)l * 8 * ADAW + (do_norm == 2 ? 3 : 0) * D;
    const int lane = F.lane;
    bf16* XN = (bf16*)(F.ws + WS_XN);
    const bf16* DB = (const bf16*)(F.ws + WS_HS);
    const v4u* route_r = (const v4u*)(F.ws + WS_ROUTE);
    int off[9], ncnt[8];
    if (do_comb) moe_offsets(F.ctl + CW_CNT + moe_prev * 8 * 64, off, ncnt);
    LAS unsigned* lcnt = (LAS unsigned*)(F.lds + RING_OFF); LAS unsigned* gbase = lcnt + 8; LAS unsigned* rec = lcnt + 16;
    float wr[4][4][8];
    float br[8];
    if (do_route) {
#pragma unroll
        for (int j = 0; j < 4; ++j)
#pragma unroll
            for (int i = 0; i < 4; ++i) { const float* p = gptr(F, IN_WR) + ((size_t)moe_i * D + 4 * lane + 256 * j + i) * 8; const f32x4 a = *(const f32x4*)p, b = *(const f32x4*)(p + 4);
                wr[j][i][0] = a[0]; wr[j][i][1] = a[1]; wr[j][i][2] = a[2]; wr[j][i][3] = a[3]; wr[j][i][4] = b[0]; wr[j][i][5] = b[1]; wr[j][i][6] = b[2]; wr[j][i][7] = b[3]; }
#pragma unroll
        for (int e = 0; e < 8; ++e) br[e] = gptr(F, IN_BR)[moe_i * 8 + e];
    }
    for (int blk = F.vcu; blk < NTOK / NQ; blk += F.G) {
        if (do_route) { if (F.tid < 8) lcnt[F.tid] = 0u; __syncthreads(); }
        for (int jr = 0; jr < 16; ++jr) {
            const int rl = F.wave * 16 + jr, row = blk * NQ + rl, b = row >> 12;
            const GAS f32x4* xr = (const GAS f32x4*)(src + (size_t)row * D) + lane;
            f32x4 v[4];
#pragma unroll
            for (int j = 0; j < 4; ++j) v[j] = xr[64 * j];
            if (do_comb) {
                const v4u rt = route_r[row]; const int e1 = rt.x & 0xff, e2 = (rt.x >> 8) & 0xff;
                int o1 = 0, o2 = 0;
#pragma unroll
                for (int e = 0; e < 8; ++e) { o1 = (e1 == e) ? off[e] : o1; o2 = (e2 == e) ? off[e] : o2; }
                const size_t r1 = (size_t)o1 + rt.y, r2 = (size_t)o2 + rt.z; const float w1 = __uint_as_float(rt.w), w2 = 1.0f - w1;
                const uint2* d1 = (const uint2*)(DB + r1 * D) + lane; const uint2* d2 = (const uint2*)(DB + r2 * D) + lane;
                const f32x4* gp = (const f32x4*)(g2prev + (size_t)b * ADAW) + lane;
#pragma unroll
                for (int j = 0; j < 4; ++j) { const uint2 a = d1[64 * j], c = d2[64 * j]; const f32x4 g = gp[64 * j];
                    f32x4 m; m[0] = w1 * bflo(a.x) + w2 * bflo(c.x); m[1] = w1 * bfhi(a.x) + w2 * bfhi(c.x); m[2] = w1 * bflo(a.y) + w2 * bflo(c.y); m[3] = w1 * bfhi(a.y) + w2 * bfhi(c.y);
                    v[j] = v[j] + g * m; }
                GAS f32x4* orow = (GAS f32x4*)(out + (size_t)row * D) + lane;
#pragma unroll
                for (int j = 0; j < 4; ++j) orow[64 * j] = v[j];
            }
            if (do_norm) {
                float s2 = 0.f;
#pragma unroll
                for (int j = 0; j < 4; ++j) s2 += (v[j].x * v[j].x + v[j].y * v[j].y) + (v[j].z * v[j].z + v[j].w * v[j].w);
                const float rstd = 1.0f / sqrtf(wave_sum(s2, lane) * (1.f / D) + EPS);
                const f32x4* gp = (const f32x4*)gain + lane; const f32x4* scp = (const f32x4*)(sc + (size_t)b * ADAW) + lane; const f32x4* shp = (const f32x4*)(sh + (size_t)b * ADAW) + lane;
                GAS unsigned long long* o8 = (GAS unsigned long long*)(XN + (size_t)row * D) + lane;
                f32x4 h[4];
#pragma unroll
                for (int j = 0; j < 4; ++j) { const f32x4 g = gp[64 * j], s = scp[64 * j], t = shp[64 * j]; h[j] = (v[j] * rstd) * g * (1.0f + s) + t;
                    o8[64 * j] = (unsigned long long)pk2(h[j].x, h[j].y) | ((unsigned long long)pk2(h[j].z, h[j].w) << 32); }
                if (do_route) {
                    float lg[8];
#pragma unroll
                    for (int e = 0; e < 8; ++e) { float a = 0.f;
#pragma unroll
                        for (int j = 0; j < 4; ++j) a += (h[j].x * wr[j][0][e] + h[j].y * wr[j][1][e]) + (h[j].z * wr[j][2][e] + h[j].w * wr[j][3][e]);
                        lg[e] = wave_sum(a, lane) + br[e]; }
                    int i1 = 0; float v1 = lg[0];
#pragma unroll
                    for (int e = 1; e < 8; ++e) if (lg[e] > v1) { v1 = lg[e]; i1 = e; }
                    int i2 = -1; float v2 = -INFINITY;
#pragma unroll
                    for (int e = 0; e < 8; ++e) if (e != i1 && lg[e] > v2) { v2 = lg[e]; i2 = e; }
                    const float w1 = 1.0f / (1.0f + expf(v2 - v1));
                    if (lane == 0) { const unsigned s1 = __hip_atomic_fetch_add(lcnt + i1, 1u, __ATOMIC_RELAXED, __HIP_MEMORY_SCOPE_WORKGROUP), s2_ = __hip_atomic_fetch_add(lcnt + i2, 1u, __ATOMIC_RELAXED, __HIP_MEMORY_SCOPE_WORKGROUP);
                        rec[rl * 4 + 0] = (unsigned)i1 | ((unsigned)i2 << 8); rec[rl * 4 + 1] = s1; rec[rl * 4 + 2] = s2_; rec[rl * 4 + 3] = __float_as_uint(w1); }
                }
            }
        }
        if (do_route) {
            __syncthreads();
            if (F.tid < 8) gbase[F.tid] = __hip_atomic_fetch_add(F.ctl + CW_CNT + (moe_i * 8 + F.tid) * 64, lcnt[F.tid], RLX_AGENT);
            __syncthreads();
            if (F.tid < NQ) { const unsigned ee = rec[F.tid * 4]; v4u o; o.x = ee; o.y = gbase[ee & 0xff] + rec[F.tid * 4 + 1]; o.z = gbase[(ee >> 8) & 0xff] + rec[F.tid * 4 + 2]; o.w = rec[F.tid * 4 + 3];
                *(GAS v4u*)((v4u*)(F.ws + WS_ROUTE) + blk * NQ + F.tid) = o; }
            __syncthreads();
        }
    }
}

__device__ __forceinline__ void moe_scatter(Frame& F, int moe_i) {
    const int gw = F.vcu * NWAVES + F.wave, NGW = F.G * NWAVES, lane = F.lane;
    int off[9], ncnt[8]; moe_offsets(F.ctl + CW_CNT + moe_i * 8 * 64, off, ncnt);
    const v4u* route_r = (const v4u*)(F.ws + WS_ROUTE); const v4u* XN = (const v4u*)(F.ws + WS_XN); v4u* HS = (v4u*)(F.ws + WS_HS);
    for (int row = gw; row < NTOK; row += NGW) {
        const v4u rt = route_r[row]; const int e1 = rt.x & 0xff, e2 = (rt.x >> 8) & 0xff; int o1 = 0, o2 = 0;
#pragma unroll
        for (int e = 0; e < 8; ++e) { o1 = (e1 == e) ? off[e] : o1; o2 = (e2 == e) ? off[e] : o2; }
        const size_t r1 = (size_t)o1 + rt.y, r2 = (size_t)o2 + rt.z;
        const v4u a = XN[(size_t)row * 128 + lane], c = XN[(size_t)row * 128 + 64 + lane];
        HS[r1 * 128 + lane] = a; HS[r1 * 128 + 64 + lane] = c; HS[r2 * 128 + lane] = a; HS[r2 * 128 + 64 + lane] = c;
    }
    int padstart[9]; padstart[0] = 0;
#pragma unroll
    for (int e = 0; e < 8; ++e) padstart[e + 1] = padstart[e] + (((ncnt[e] + 255) & ~255) - ncnt[e]);
    for (int p = gw; p < padstart[8]; p += NGW) {
        int row = 0;
#pragma unroll
        for (int e = 0; e < 8; ++e) if (p >= padstart[e] && p < padstart[e + 1]) row = off[e] + ncnt[e] + (p - padstart[e]);
        const v4u z = (v4u){0u, 0u, 0u, 0u}; HS[(size_t)row * 128 + lane] = z; HS[(size_t)row * 128 + 64 + lane] = z;
    }
}

__device__ __forceinline__ void prep_phase(Frame& F, int l) {
    const int gw = F.vcu * NWAVES + F.wave, NGW = F.G * NWAVES, lane = F.lane;
    unsigned char* act = F.ws + WS_ACT;
    {
        float gq[16], gk[16];
#pragma unroll
        for (int i = 0; i < 16; ++i) { gq[i] = gptr(F, IN_QG)[l * 64 + (lane & 3) * 16 + i] * (0.125f * LOG2E); gk[i] = gptr(F, IN_KG)[l * 64 + (lane & 3) * 16 + i]; }
        for (int it = gw; it < 2 * NTOK; it += NGW) {
            const int which = it & 1, row = it >> 1;
            v4u* p = (v4u*)(act + (size_t)which * ACTB + (size_t)row * 2048) + 2 * lane;
            const v4u a = p[0], c = p[1]; float x[16];
            x[0] = bflo(a.x); x[1] = bfhi(a.x); x[2] = bflo(a.y); x[3] = bfhi(a.y); x[4] = bflo(a.z); x[5] = bfhi(a.z); x[6] = bflo(a.w); x[7] = bfhi(a.w);
            x[8] = bflo(c.x); x[9] = bfhi(c.x); x[10] = bflo(c.y); x[11] = bfhi(c.y); x[12] = bflo(c.z); x[13] = bfhi(c.z); x[14] = bflo(c.w); x[15] = bfhi(c.w);
            float ss = 0.f;
#pragma unroll
            for (int i = 0; i < 16; ++i) ss += x[i] * x[i];
            ss += shfl_idx(ss, lane ^ 1); ss += shfl_idx(ss, lane ^ 2);
            const float rstd = 1.0f / sqrtf(ss * (1.0f / 64.0f) + EPS);
#pragma unroll
            for (int i = 0; i < 16; ++i) x[i] = x[i] * rstd * (which ? gk[i] : gq[i]);
            v4u oa, oc; oa.x = pk2(x[0], x[1]); oa.y = pk2(x[2], x[3]); oa.z = pk2(x[4], x[5]); oa.w = pk2(x[6], x[7]); oc.x = pk2(x[8], x[9]); oc.y = pk2(x[10], x[11]); oc.z = pk2(x[12], x[13]); oc.w = pk2(x[14], x[15]);
            p[0] = oa; p[1] = oc;
        }
    }
    {
        const float* LF = (const float*)(F.ws + WS_LF); float* Fo = (float*)(F.ws + WS_F);
        for (int bh = gw; bh < BATCH * 16; bh += NGW) {
            const int b = bh >> 4, h = bh & 15; const float* src = LF + ((size_t)b * SEQ + 64 * lane) * 16 + h;
            float v[64]; float tot = 0.f;
#pragma unroll
            for (int i = 0; i < 64; ++i) { v[i] = src[(size_t)i * 16]; }
#pragma unroll
            for (int i = 0; i < 64; ++i) { tot += v[i]; v[i] = tot; }
            float pre = tot;
#pragma unroll
            for (int o = 1; o < 64; o <<= 1) { const float t = shfl_idx(pre, lane - o); if (lane >= o) pre += t; }
            pre -= tot;
            f32x4* dst = (f32x4*)(Fo + (size_t)bh * SEQ + 64 * lane);
#pragma unroll
            for (int i = 0; i < 16; ++i) dst[i] = (f32x4){(v[4 * i] + pre) * LOG2E, (v[4 * i + 1] + pre) * LOG2E, (v[4 * i + 2] + pre) * LOG2E, (v[4 * i + 3] + pre) * LOG2E};
        }
    }
    {
        LAS unsigned char* sb = F.lds + RING_OFF + F.wave * 16384;
        LAS unsigned short* Zs = (LAS unsigned short*)sb; LAS unsigned short* Qs = (LAS unsigned short*)(sb + 4608); LAS unsigned short* Vs = (LAS unsigned short*)(sb + 9216);
        const bf16* HQ = (const bf16*)(act + 3 * ACTB); const bf16* HF = (const bf16*)(act + 4 * ACTB); const bf16* HI = (const bf16*)(act + 5 * ACTB);
        bf16* KTt = (bf16*)(act + 9 * ACTB); bf16* VT = (bf16*)(act + 10 * ACTB); float* DL = (float*)(F.ws + WS_DL);
        const float* lbp = (const float*)(F.ws + WS_LB) + l * 1024;
        const int r = lane >> 1, c0 = (lane & 1) * 32;
        for (int it = gw; it < 1024 * 16; it += NGW) {
            const int ck = it >> 4, cg = it & 15; const size_t rowoff = ((size_t)ck * 32 + r) * D + 64 * cg + c0;
            {
                const v4u* pz = (const v4u*)(HF + rowoff); const v4u* pq = (const v4u*)(HQ + rowoff); const v4u* pv = (const v4u*)(HI + rowoff);
#pragma unroll
                for (int k = 0; k < 4; ++k) { *(LAS v4u*)(Zs + r * 72 + c0 + 8 * k) = pz[k]; *(LAS v4u*)(Qs + r * 72 + c0 + 8 * k) = pq[k]; *(LAS v4u*)(Vs + r * 72 + c0 + 8 * k) = pv[k]; }
            }
            LDS_WAIT(); __builtin_amdgcn_wave_barrier(); asm volatile("" ::: "memory");
            {
                const int ch = 64 * cg + lane; const float lb = lbp[ch], oml = 1.0f - lb;
                float G = 0.f; unsigned kt[16], vt[16];
#pragma unroll
                for (int t = 0; t < 32; ++t) {
                    const float z = bf2f(Zs[t * 72 + lane]), q = bf2f(Qs[t * 72 + lane]); const unsigned short vraw = Vs[t * 72 + lane];
                    const float e = __expf(-z), inv = 1.0f / (1.0f + e);
                    const float f = lb + oml * inv, kk = oml * (e * inv);
                    G += __logf(fmaxf(f, 1e-20f));
                    const float qt = q * __expf(G), ktv = kk * __expf(fminf(-G, 80.0f));
                    const unsigned kb_ = f2bf(ktv);
                    Qs[t * 72 + lane] = (unsigned short)f2bf(qt); Zs[t * 72 + lane] = (unsigned short)kb_;
                    if (t & 1) { kt[t >> 1] |= kb_ << 16; vt[t >> 1] |= (unsigned)vraw << 16; } else { kt[t >> 1] = kb_; vt[t >> 1] = (unsigned)vraw; }
                }
                DL[(size_t)ck * 1024 + ch] = __expf(G);
                v4u* pk = (v4u*)(KTt + ((size_t)ck * 1024 + ch) * 32); v4u* pv = (v4u*)(VT + ((size_t)ck * 1024 + ch) * 32);
#pragma unroll
                for (int k = 0; k < 4; ++k) { pk[k] = (v4u){kt[4 * k], kt[4 * k + 1], kt[4 * k + 2], kt[4 * k + 3]}; pv[k] = (v4u){vt[4 * k], vt[4 * k + 1], vt[4 * k + 2], vt[4 * k + 3]}; }
            }
            LDS_WAIT(); __builtin_amdgcn_wave_barrier(); asm volatile("" ::: "memory");
            {
                v4u* pz = (v4u*)((bf16*)(act + 4 * ACTB) + rowoff); v4u* pq = (v4u*)((bf16*)(act + 3 * ACTB) + rowoff);
#pragma unroll
                for (int k = 0; k < 4; ++k) { pz[k] = *(const LAS v4u*)(Zs + r * 72 + c0 + 8 * k); pq[k] = *(const LAS v4u*)(Qs + r * 72 + c0 + 8 * k); }
            }
            LDS_WAIT(); __builtin_amdgcn_wave_barrier(); asm volatile("" ::: "memory");
        }
    }
}

typedef float f32x16 __attribute__((ext_vector_type(16)));
#define MFMA32(a, b, c) __builtin_amdgcn_mfma_f32_32x32x16_bf16(a, b, c, 0, 0, 0)
__device__ __forceinline__ bf16x8 pack8(const f32x16& x, int s) {
    v4u w; w.x = pk2(x[8 * s], x[8 * s + 1]); w.y = pk2(x[8 * s + 2], x[8 * s + 3]); w.z = pk2(x[8 * s + 4], x[8 * s + 5]); w.w = pk2(x[8 * s + 6], x[8 * s + 7]);
    return __builtin_bit_cast(bf16x8, w);
}
template <bool OUT> __device__ __forceinline__ void hg_task(Frame& F, int unit, int vb) {
    const int lane = F.lane, r32 = lane & 31, hi = lane >> 5, pi = (r32 & ~12) | ((r32 & 4) << 1) | ((r32 & 8) >> 1);
    const int bh = unit >> 4, sc = unit & 15, b = bh >> 3, h = bh & 7;
    const int tok0 = b * SEQ + sc * 256, ck0 = tok0 >> 5;
    unsigned char* act = F.ws + WS_ACT;
    const bf16* QT = (const bf16*)(act + 3 * ACTB); const bf16* KT = (const bf16*)(act + 4 * ACTB); bf16* OH = (bf16*)(act + 5 * ACTB);
    const bf16* KTt = (const bf16*)(act + 9 * ACTB); const bf16* VT = (const bf16*)(act + 10 * ACTB); const float* DL = (const float*)(F.ws + WS_DL);
    float* U = (float*)(F.ws + WS_U); float* DSC = (float*)(F.ws + WS_DSC);
    f32x16 S[4];
#pragma unroll
    for (int kb = 0; kb < 4; ++kb) S[kb] = f32x16{};
    if (OUT) {
        for (int j = 0; j < sc; ++j) { const int uj = bh * 16 + j;
#pragma unroll
            for (int kb = 0; kb < 4; ++kb) { const float* dp = DSC + (size_t)uj * 128 + 32 * kb + 8 * hi; const f32x4 d0 = *(const f32x4*)dp, d1 = *(const f32x4*)(dp + 4), d2 = *(const f32x4*)(dp + 16), d3 = *(const f32x4*)(dp + 20);
                const float dd[16] = {d0[0], d0[1], d0[2], d0[3], d1[0], d1[1], d1[2], d1[3], d2[0], d2[1], d2[2], d2[3], d3[0], d3[1], d3[2], d3[3]};
                const float* up = U + (((size_t)uj * 4 + vb) * 64 + kb * 16) * 64 + lane;
#pragma unroll
                for (int r = 0; r < 16; ++r) S[kb][r] = S[kb][r] * dd[r] + up[(size_t)r * 64]; } }
    }
    bf16x8 Sb[4][2];
    if (OUT) {
#pragma unroll
        for (int kb = 0; kb < 4; ++kb) { Sb[kb][0] = pack8(S[kb], 0); Sb[kb][1] = pack8(S[kb], 1); }
    }
    for (int j = 0; j < 8; ++j) {
        const int ck = ck0 + j, tokc = tok0 + 32 * j;
        bf16x8 vt[2];
#pragma unroll
        for (int st = 0; st < 2; ++st) vt[st] = *(const bf16x8*)(VT + ((size_t)ck * 1024 + 128 * h + 32 * vb + r32) * 32 + 16 * st + 8 * hi);
        if (OUT) {
            bf16x8 qf[8]; f32x16 X = f32x16{};
#pragma unroll
            for (int ks = 0; ks < 8; ++ks) { const bf16x8 ka = *(const bf16x8*)(KT + (size_t)(tokc + pi) * D + 128 * h + 16 * ks + 8 * hi); qf[ks] = *(const bf16x8*)(QT + (size_t)(tokc + r32) * D + 128 * h + 16 * ks + 8 * hi);
                X = MFMA32(ka, qf[ks], X); }
#pragma unroll
            for (int r = 0; r < 16; ++r) { const int s = 16 * (r >> 3) + 8 * hi + (r & 7); X[r] = (s > r32) ? 0.f : X[r]; }
            const bf16x8 P0 = pack8(X, 0), P1 = pack8(X, 1);
            f32x16 o = f32x16{};
            o = MFMA32(P0, vt[0], o); o = MFMA32(P1, vt[1], o);
#pragma unroll
            for (int kb = 0; kb < 4; ++kb) { o = MFMA32(qf[2 * kb], Sb[kb][0], o); o = MFMA32(qf[2 * kb + 1], Sb[kb][1], o); }
            bf16* op = OH + (size_t)tokc * D + 128 * h + 32 * vb + r32;
#pragma unroll
            for (int r = 0; r < 16; ++r) { const int t = 8 * (r >> 2) + 4 * hi + (r & 3); op[(size_t)t * D] = (bf16)f2bf(o[r]); }
        }
#pragma unroll
        for (int kb = 0; kb < 4; ++kb) {
#pragma unroll
            for (int st = 0; st < 2; ++st) { const bf16x8 kf = *(const bf16x8*)(KTt + ((size_t)ck * 1024 + 128 * h + 32 * kb + pi) * 32 + 16 * st + 8 * hi); S[kb] = MFMA32(kf, vt[st], S[kb]); }
            const float* dp = DL + (size_t)ck * 1024 + 128 * h + 32 * kb + 8 * hi; const f32x4 d0 = *(const f32x4*)dp, d1 = *(const f32x4*)(dp + 4), d2 = *(const f32x4*)(dp + 16), d3 = *(const f32x4*)(dp + 20);
            const float dd[16] = {d0[0], d0[1], d0[2], d0[3], d1[0], d1[1], d1[2], d1[3], d2[0], d2[1], d2[2], d2[3], d3[0], d3[1], d3[2], d3[3]};
#pragma unroll
            for (int r = 0; r < 16; ++r) S[kb][r] *= dd[r];
            if (OUT) { Sb[kb][0] = pack8(S[kb], 0); Sb[kb][1] = pack8(S[kb], 1); }
        }
    }
    if (!OUT) {
#pragma unroll
        for (int kb = 0; kb < 4; ++kb) { float* up = U + (((size_t)unit * 4 + vb) * 64 + kb * 16) * 64 + lane;
#pragma unroll
            for (int r = 0; r < 16; ++r) up[(size_t)r * 64] = S[kb][r]; }
        if (vb == 0) {
#pragma unroll
            for (int half = 0; half < 2; ++half) { const int ch = lane + 64 * half; float p = 1.0f;
                for (int j = 0; j < 8; ++j) p *= DL[(size_t)(ck0 + j) * 1024 + 128 * h + ch];
                DSC[(size_t)unit * 128 + ch] = p; }
        }
    }
}
template <bool OUT> __device__ __forceinline__ void hg_phase(Frame& F) {
    const int gw = F.vcu * NWAVES + F.wave, NGW = F.G * NWAVES;
    for (int t = gw; t < 4096; t += NGW) hg_task<OUT>(F, t >> 2, t & 3);
}

__device__ __forceinline__ void merge_phase(Frame& F, int l) {
    const int gw = F.vcu * NWAVES + F.wave, NGW = F.G * NWAVES, lane = F.lane;
    unsigned char* act = F.ws + WS_ACT;
    float og[16];
#pragma unroll
    for (int i = 0; i < 16; ++i) og[i] = gptr(F, IN_OG)[l * 128 + (lane & 7) * 16 + i];
    for (int row = gw; row < NTOK; row += NGW) {
        const size_t ro = (size_t)row * 2048 + 32 * lane;
        const v4u* pa = (const v4u*)(act + 0 * ACTB + ro); const v4u* ph = (const v4u*)(act + 5 * ACTB + ro); const v4u* pg = (const v4u*)(act + 6 * ACTB + ro);
        const v4u* pga = (const v4u*)(act + 7 * ACTB + ro); const v4u* pgb = (const v4u*)(act + 8 * ACTB + ro);
        v4u out[2]; float oh[16];
#pragma unroll
        for (int k = 0; k < 2; ++k) { const v4u w = ph[k]; oh[8 * k] = bflo(w.x); oh[8 * k + 1] = bfhi(w.x); oh[8 * k + 2] = bflo(w.y); oh[8 * k + 3] = bfhi(w.y); oh[8 * k + 4] = bflo(w.z); oh[8 * k + 5] = bfhi(w.z); oh[8 * k + 6] = bflo(w.w); oh[8 * k + 7] = bfhi(w.w); }
        float ss = 0.f;
#pragma unroll
        for (int i = 0; i < 16; ++i) ss += oh[i] * oh[i];
        ss += shfl_idx(ss, lane ^ 1); ss += shfl_idx(ss, lane ^ 2); ss += shfl_idx(ss, lane ^ 4);
        const float rstd = 1.0f / sqrtf(ss * (1.0f / 128.0f) + EPS);
#pragma unroll
        for (int k = 0; k < 2; ++k) { const v4u wa = pa[k], wg = pg[k], wga = pga[k], wgb = pgb[k]; float y[8];
            const unsigned aw[4] = {wa.x, wa.y, wa.z, wa.w}, gw_[4] = {wg.x, wg.y, wg.z, wg.w}, gaw[4] = {wga.x, wga.y, wga.z, wga.w}, gbw[4] = {wgb.x, wgb.y, wgb.z, wgb.w};
#pragma unroll
            for (int q = 0; q < 4; ++q) {
                y[2 * q] = bflo(gaw[q]) * bflo(aw[q]) + bflo(gbw[q]) * (oh[8 * k + 2 * q] * rstd * og[8 * k + 2 * q] * bflo(gw_[q]));
                y[2 * q + 1] = bfhi(gaw[q]) * bfhi(aw[q]) + bfhi(gbw[q]) * (oh[8 * k + 2 * q + 1] * rstd * og[8 * k + 2 * q + 1] * bfhi(gw_[q])); }
            out[k] = (v4u){pk2(y[0], y[1]), pk2(y[2], y[3]), pk2(y[4], y[5]), pk2(y[6], y[7])}; }
        v4u* po = (v4u*)(F.ws + WS_XN + ro); po[0] = out[0]; po[1] = out[1];
    }
}

struct Args { const float* in[21]; float* out; unsigned char* ws; int ph_lo, ph_hi; };
__global__ void __launch_bounds__(NWAVES * 64, 2) trunk_fwd(Args args) {
    extern __shared__ __attribute__((aligned(16))) unsigned char lds[];
    Frame F;
    F.lds = (LAS unsigned char*)lds;
    F.MISC = (volatile LAS unsigned*)(F.lds + MISC_OFF);
    F.tid = threadIdx.x; F.lane = F.tid & 63; F.wave = __builtin_amdgcn_readfirstlane(F.tid >> 6);
    F.G = gridDim.x; { const int bx = blockIdx.x; F.vcu = (F.G % 8 == 0) ? (bx % 8) * (F.G / 8) + bx / 8 : bx; }
    F.ws = args.ws; F.ctl = (gu32*)(args.ws + WS_CTL);
    for (int u = F.tid; u < (LDS_BYTES - LDSCTL_OFF) / 4; u += NWAVES * 64) ((LAS unsigned*)(F.lds + LDSCTL_OFF))[u] = 0u;
    __syncthreads();
    if (F.tid < 22) { const unsigned long long p = (F.tid < 21) ? (unsigned long long)args.in[F.tid] : (unsigned long long)args.out;
        LAS unsigned* t = (LAS unsigned*)(F.lds + PTAB_OFF) + 2 * F.tid; t[0] = (unsigned)p; t[1] = (unsigned)(p >> 32); }
    __syncthreads();
    XcdBarrier bar = xcd_barrier_post((unsigned*)(F.ctl + CW_BAR), F.MISC + 8);
#define GRID_BAR() do { XcdBarrier b_ = bar; asm volatile("" : "+s"(b_.bar)); xcd_barrier(b_); } while (0)
    const int lo = args.ph_lo, hi = args.ph_hi; int ph = 0;
#define PHASE_BEGIN if (ph >= lo && ph < hi) { Frame P = F; asm volatile("" : "+v"(P.tid)); asm volatile("" : "+s"(P.ws)); P.lane = P.tid & 63; P.wave = __builtin_amdgcn_readfirstlane(P.tid >> 6); P.ctl = (gu32*)P.ws;
#define PHASE_END   if (ph + 1 < hi) GRID_BAR(); } ++ph;

    PHASE_BEGIN p0_prologue(P); PHASE_END
    PHASE_BEGIN ada_final(P); PHASE_END

    for (int l = 0; l < DEPTH; ++l) {
        const bool moe = (l & 1); const int fi = l >> 1;
        PHASE_BEGIN row_phase(P, l == 0, (l > 0) && ((l - 1) & 1), l > 0 ? l - 1 : 0, 1, l, false); PHASE_END
        PHASE_BEGIN {
            pg8::Gemm g{(const bf16*)(P.ws + WS_XN), (const bf16*)(P.ws + WS_WIN) + (size_t)l * D_INP * D, NTOK, D_INP, D}; pg8::TileOrder S; S.init(NTOK / 256, D_INP / 256, P.G, (int)blockIdx.x);
            pg8::EpiInProj E{(bf16*)(P.ws + WS_ACT), ACTB / 2, (float*)(P.ws + WS_LF), gptr(P, IN_FB) + l * 16};
            pg8::gemm_phase<pg8::EpiInProj, pg8::TileOrder, PG8_ALIGN, PG8_SP2>(P.lds + RING_OFF, g, S, E, P.tid);
        } PHASE_END
        PHASE_BEGIN prep_phase(P, l); PHASE_END
        PHASE_BEGIN {
            hg_phase<false>(P);
            __syncthreads();
            unsigned char* act = P.ws + WS_ACT;
            const attn_body::AttnTensors AT{(const attn_body::bf16*)(act + 0 * ACTB), (const attn_body::bf16*)(act + 1 * ACTB), (const attn_body::bf16*)(act + 2 * ACTB), (attn_body::bf16*)(act + 0 * ACTB), (const float*)(P.ws + WS_F)};
            const attn_body::StaticOrder S((int)P.G, P.vcu);
            attn_body::attn_phase<attn_body::StaticOrder>((char*)lds + RING_OFF, AT, S, P.tid);
        } PHASE_END
        PHASE_BEGIN hg_phase<true>(P); PHASE_END
        PHASE_BEGIN merge_phase(P, l); PHASE_END
        PHASE_BEGIN {
            pg8::Gemm g{(const bf16*)(P.ws + WS_XN), (const bf16*)(P.ws + WS_WOUT) + (size_t)l * D * D, NTOK, D, D}; pg8::TileOrder S; S.init(NTOK / 256, D / 256, P.G, (int)blockIdx.x);
            float* const out = gptr(P, IN_OUT);
            pg8::EpiResid E{l == 0 ? (const float*)gptr(P, IN_X) : (const float*)out, out, (const float*)(P.ws + WS_ADA) + (size_t)l * 8 * ADAW + 2 * D, ADAW, nullptr, 0};
            pg8::gemm_phase<pg8::EpiResid, pg8::TileOrder, PG8_ALIGN, PG8_SP2>(P.lds + RING_OFF, g, S, E, P.tid);
        } PHASE_END
        PHASE_BEGIN row_phase(P, false, false, 0, 2, l, moe); if (moe) { __syncthreads(); moe_weights(P, fi); } PHASE_END
        if (moe) { PHASE_BEGIN moe_scatter(P, fi); PHASE_END }
        PHASE_BEGIN {
            pg8::TileOrder S; pg8::Gemm g; pg8::EpiSwiGLU E;
            if (moe) { int off[9], ncnt[8]; moe_offsets(P.ctl + CW_CNT + fi * 8 * 64, off, ncnt); S.init(off[8] >> 8, 2 * DFE / 256, P.G, (int)blockIdx.x); S.nbt = 2 * DFE / 256;
#pragma unroll
                for (int e = 0; e < 8; ++e) S.cum[e] = off[e] >> 8;
                g = pg8::Gemm{(const bf16*)(P.ws + WS_HS), (const bf16*)(P.ws + WS_WMGU), off[8], 2 * DFE, D};
                E = pg8::EpiSwiGLU{(bf16*)(P.ws + WS_INTER_M), DFE};
            } else {
                S.init(NTOK / 256, 2 * DFF / 256, P.G, (int)blockIdx.x);
                g = pg8::Gemm{(const bf16*)(P.ws + WS_XN), (const bf16*)(P.ws + WS_WGU) + (size_t)fi * 2 * DFF * D, NTOK, 2 * DFF, D};
                E = pg8::EpiSwiGLU{(bf16*)(P.ws + WS_INTER_D), DFF};
            }
            pg8::gemm_phase<pg8::EpiSwiGLU, pg8::TileOrder, PG8_ALIGN, PG8_SP2>(P.lds + RING_OFF, g, S, E, P.tid);
        } PHASE_END
        PHASE_BEGIN {
            pg8::TileOrder S; pg8::Gemm g; pg8::EpiResid E;
            if (moe) { int off[9], ncnt[8]; moe_offsets(P.ctl + CW_CNT + fi * 8 * 64, off, ncnt); S.init(off[8] >> 8, D / 256, P.G, (int)blockIdx.x); S.nbt = D / 256;
#pragma unroll
                for (int e = 0; e < 8; ++e) S.cum[e] = off[e] >> 8;
                g = pg8::Gemm{(const bf16*)(P.ws + WS_INTER_M), (const bf16*)(P.ws + WS_WMDN), off[8], D, DFE};
                E = pg8::EpiResid{nullptr, nullptr, nullptr, 0, (bf16*)(P.ws + WS_HS), 1};
            } else {
                S.init(NTOK / 256, D / 256, P.G, (int)blockIdx.x);
                float* const out = gptr(P, IN_OUT);
                g = pg8::Gemm{(const bf16*)(P.ws + WS_INTER_D), (const bf16*)(P.ws + WS_WDN) + (size_t)fi * D * DFF, NTOK, D, DFF};
                E = pg8::EpiResid{out, out, (const float*)(P.ws + WS_ADA) + (size_t)l * 8 * ADAW + 5 * D, ADAW, nullptr, 0};
            }
            pg8::gemm_phase<pg8::EpiResid, pg8::TileOrder, PG8_ALIGN, PG8_SP2>(P.lds + RING_OFF, g, S, E, P.tid);
        } PHASE_END
    }
    PHASE_BEGIN row_phase(P, false, true, 3, 0, 0, false); PHASE_END
#undef PHASE_BEGIN
#undef PHASE_END
}

#ifndef MK_SPLIT
#define MK_SPLIT 0
#endif
constexpr int N_PHASES = 2 + 4 * 10 + 2 * 1 + 1;
extern "C" void kernel_launch(void* const* d_in, const int* in_sizes, int n_in, void* d_out, int out_size, void* d_ws, size_t ws_size, hipStream_t stream) {
    static int grid = 0;
    if (grid == 0) {
        if (n_in != 21 || out_size != NTOK * D || ws_size < WS_END) { fprintf(stderr, "kernel_launch: unexpected sizes (n_in %d out %d ws %zu need %zu)\n", n_in, out_size, ws_size, (size_t)WS_END); grid = -1; return; }
        int dev = 0, cus = 0, per_cu = 0;
        if (hipGetDevice(&dev) != hipSuccess || hipDeviceGetAttribute(&cus, hipDeviceAttributeMultiprocessorCount, dev) != hipSuccess) { grid = -1; return; }
        if (hipFuncSetAttribute((const void*)trunk_fwd, hipFuncAttributeMaxDynamicSharedMemorySize, LDS_BYTES) != hipSuccess) { grid = -1; return; }
        if (hipOccupancyMaxActiveBlocksPerMultiprocessor(&per_cu, (const void*)trunk_fwd, NWAVES * 64, LDS_BYTES) != hipSuccess || per_cu < 1) fprintf(stderr, "kernel_launch: occupancy query says %d\n", per_cu);
        (void)hipGetLastError();
        grid = cus;
    }
    if (grid < 0) return;
    if (hipMemsetAsync((char*)d_ws + WS_CTL, 0, CTL_ZERO_BYTES, stream) != hipSuccess) return;
    Args a{};
    for (int i = 0; i < 21; ++i) a.in[i] = (const float*)d_in[i];
    a.out = (float*)d_out; a.ws = (unsigned char*)d_ws;
#if MK_SPLIT
    for (int p = 0; p < N_PHASES; ++p) { a.ph_lo = p; a.ph_hi = p + 1; hipLaunchKernelGGL(trunk_fwd, dim3(grid), dim3(NWAVES * 64), LDS_BYTES, stream, a); }
#else
    a.ph_lo = 0; a.ph_hi = N_PHASES;
    hipLaunchKernelGGL(trunk_fwd, dim3(grid), dim3(NWAVES * 64), LDS_BYTES, stream, a);
#endif
}
```

```cpp
#include <hip/hip_runtime.h>
#include <hip/hip_bf16.h>
#include <cstdio>
#include <cstdint>
#include <cmath>
namespace pg8 {
#define PG8_LAS __attribute__((address_space(3)))
typedef unsigned short bf16_t;
typedef short bf16x8 __attribute__((ext_vector_type(8)));
typedef float f32x4 __attribute__((ext_vector_type(4)));
typedef unsigned u32x4 __attribute__((ext_vector_type(4)));
constexpr int BM = 256, BK = 64, HALF = 128, HTB = HALF * BK * 2  , STAGE_BYTES = 8 * HTB, NXCD = 8, WGM = 8;

__host__ __device__ __forceinline__ int lds_byte(int r, int c) { const int st = (r >> 4) * 2 + (c >> 5), rr = r & 15, cc = c & 31, ob = rr * 64 + cc * 2; return st * 1024 + (ob ^ (((ob >> 9) & 1) << 5)); }
__host__ __device__ __forceinline__ void stage_rc(int b, int& R, int& C) { const int st = b / 1024, sb = b % 1024, swz = sb ^ (((sb >> 9) & 1) << 5); R = (st >> 1) * 16 + swz / 64; C = (st & 1) * 32 + (swz % 64) / 2; }
__host__ __device__ __forceinline__ int perm32(int rho) { const int n = rho >> 4, i = rho & 15; return 8 * (i >> 2) + 4 * n + (i & 3); }

struct Unit { int pm, pn, pb; };
struct Gemm { const bf16_t* A; const bf16_t* Bt; int M, N, K; };

struct TileOrder {
    int nM, nN, nwg, G, c, nbt; int cum[8]; int rm_from, rm_to, pn_off, bal, tmode;
    __device__ __forceinline__ void init(int nM_, int nN_, int G_, int c_) { nM = nM_; nN = nN_; nwg = nM * nN; G = G_; c = c_; nbt = 0; rm_from = -1; rm_to = 0; pn_off = 0; bal = 0; tmode = 0;
#pragma unroll
        for (int k = 0; k < 8; ++k) cum[k] = 0x7fffffff; }
    __device__ __forceinline__ bool next(int i, Unit& u) const {
        long L = (long)i * G + c;
        if (bal > 0 && i >= bal) { if (c < G / 2 || i >= bal + 2) return false; L = (long)bal * G + (long)(i - bal) * (G / 2) + (c - G / 2); }
        if (L >= nwg) return false;
        int wgid = (int)L; { const int q = nwg / NXCD, r = nwg % NXCD, xcd = wgid % NXCD, off = wgid / NXCD; wgid = (xcd < r ? xcd * (q + 1) : r * (q + 1) + (xcd - r) * q) + off; }
        const int nig = WGM * nN, gid = wgid / nig, fm = gid * WGM, gsz = (nM - fm) < WGM ? (nM - fm) : WGM;
        u.pm = fm + ((wgid % nig) % gsz); u.pn = (wgid % nig) / gsz;
        int e = 0;
#pragma unroll
        for (int k = 1; k < 8; ++k) e += (u.pm >= cum[k]) ? 1 : 0;
        int pnl = (u.pn == rm_from) ? rm_to : u.pn;
        if (tmode == 1) { pnl = pnl < 8 ? pnl : 36; u.pb = pnl; u.pn = pnl; return true; }
        if (tmode == 2) { u.pb = pnl; u.pn = pnl; return true; }
        u.pb = e * nbt + pnl; u.pn = pnl + pn_off; return true;
    }
    __device__ __forceinline__ void a_ready(const Unit&) const {}
    __device__ __forceinline__ void done(const Unit&) const {}
};

__device__ __forceinline__ unsigned cvt_pk_bf16(float lo, float hi) { unsigned r; asm volatile("v_cvt_pk_bf16_f32 %0, %1, %2" : "=v"(r) : "v"(lo), "v"(hi)); return r; }
__device__ __forceinline__ unsigned pk_fp8x4(float a, float b, float c, float d) { unsigned w = 0; w = __builtin_amdgcn_cvt_pk_fp8_f32(a, b, w, false); w = __builtin_amdgcn_cvt_pk_fp8_f32(c, d, w, true); return w; }
typedef unsigned u32x2 __attribute__((ext_vector_type(2)));
__device__ __forceinline__ float sigmoid_f(float v) { return __builtin_amdgcn_rcpf(1.0f + __builtin_amdgcn_exp2f(-1.4426950408889634f * v)); }
__device__ __forceinline__ f32x4 sigmoid4(f32x4 v) { return (f32x4){sigmoid_f(v[0]), sigmoid_f(v[1]), sigmoid_f(v[2]), sigmoid_f(v[3])}; }

struct EpiInProj {
    static constexpr bool PERM = true, AFTER_DRAIN = false;
    bf16_t* base; size_t bufstride; float* LF; const float* fbias; const float* qgain; const float* kgain; float s;
    __device__ __forceinline__ void operator()(const f32x4 (&acc)[2][2][4][2], const Unit& u, int wr, int wc, int fr, int fq) const {
        const int row0 = u.pm * BM + wr * 64 + fr;
        if (u.pn < 8) {
            const bool isq = u.pn < 4; const float* gp = (isq ? qgain : kgain) + 8 * fq; const float gs = isq ? 0.125f * 1.4426950408889634f : 1.0f;
            f32x4 gv[2][2];
#pragma unroll
            for (int bj = 0; bj < 2; ++bj)
#pragma unroll
                for (int n = 0; n < 2; ++n) gv[bj][n] = *(const f32x4*)(gp + 32 * bj + 4 * n) * gs;
            bf16_t* b = base + (size_t)(u.pn >> 2) * bufstride; const int col0 = 64 * (4 * (u.pn & 3) + wc) + 8 * fq;
#pragma unroll
            for (int ai = 0; ai < 2; ++ai)
#pragma unroll
                for (int m = 0; m < 4; ++m) { float ss = 0.f;
#pragma unroll
                    for (int bj = 0; bj < 2; ++bj)
#pragma unroll
                        for (int n = 0; n < 2; ++n) { const f32x4 x = acc[ai][bj][m][n]; ss += (x[0] * x[0] + x[1] * x[1]) + (x[2] * x[2] + x[3] * x[3]); }
                    { const unsigned su = __float_as_uint(ss); const auto r16 = __builtin_amdgcn_permlane16_swap(su, su, false, false); ss = __uint_as_float(r16[0]) + __uint_as_float(r16[1]); }
                    { const unsigned su = __float_as_uint(ss); const auto r32 = __builtin_amdgcn_permlane32_swap(su, su, false, false); ss = __uint_as_float(r32[0]) + __uint_as_float(r32[1]); }
                    const float rstd = s / sqrtf(ss * (s * s) * (1.0f / 64.0f) + 1e-6f);
                    bf16_t* rowp = b + (size_t)(row0 + ai * HALF + m * 16) * 1024 + col0;
#pragma unroll
                    for (int bj = 0; bj < 2; ++bj) { const f32x4 v0 = acc[ai][bj][m][0] * rstd * gv[bj][0], v1 = acc[ai][bj][m][1] * rstd * gv[bj][1];
                        u32x4 w; w.x = cvt_pk_bf16(v0[0], v0[1]); w.y = cvt_pk_bf16(v0[2], v0[3]); w.z = cvt_pk_bf16(v1[0], v1[1]); w.w = cvt_pk_bf16(v1[2], v1[3]);
                        __builtin_nontemporal_store(w, (u32x4*)(rowp + 32 * bj)); } }
        } else if ((u.pn >= 12 && u.pn < 20) || (u.pn >= 28 && u.pn < 36)) {
            unsigned char* b8 = (unsigned char*)(base + (size_t)(u.pn >> 2) * bufstride); const int colA = (u.pn & 3) * 256 + wc * 64 + 16 * fq;
#pragma unroll
            for (int ai = 0; ai < 2; ++ai)
#pragma unroll
                for (int m = 0; m < 4; ++m) { const f32x4 a0 = acc[ai][0][m][0] * s, a1 = acc[ai][0][m][1] * s, c0 = acc[ai][1][m][0] * s, c1 = acc[ai][1][m][1] * s;
                    u32x4 w; w.x = pk_fp8x4(a0[0], a0[1], a0[2], a0[3]); w.y = pk_fp8x4(a1[0], a1[1], a1[2], a1[3]); w.z = pk_fp8x4(c0[0], c0[1], c0[2], c0[3]); w.w = pk_fp8x4(c1[0], c1[1], c1[2], c1[3]);
                    __builtin_nontemporal_store(w, (u32x4*)(b8 + (size_t)(row0 + ai * HALF + m * 16) * 1024 + colA)); }
        } else if (u.pn < 36) {
            const int t = u.pn >> 2;
            bf16_t* b = base + (size_t)t * bufstride; const int col0 = (u.pn & 3) * 256 + wc * 32 + 8 * fq;
#pragma unroll
            for (int ai = 0; ai < 2; ++ai)
#pragma unroll
                for (int m = 0; m < 4; ++m) { bf16_t* rowp = b + (size_t)(row0 + ai * HALF + m * 16) * 1024 + col0;
#pragma unroll
                    for (int bj = 0; bj < 2; ++bj) { const f32x4 v0 = acc[ai][bj][m][0] * s, v1 = acc[ai][bj][m][1] * s;
                        u32x4 w; w.x = cvt_pk_bf16(v0[0], v0[1]); w.y = cvt_pk_bf16(v0[2], v0[3]); w.z = cvt_pk_bf16(v1[0], v1[1]); w.w = cvt_pk_bf16(v1[2], v1[3]);
                        __builtin_nontemporal_store(w, (u32x4*)(rowp + bj * HALF)); } }
        } else if (wc == 0 && fq < 2) {
#pragma unroll
            for (int n = 0; n < 2; ++n) { const f32x4 bv = *(const f32x4*)(fbias + 8 * fq + 4 * n);
#pragma unroll
                for (int ai = 0; ai < 2; ++ai)
#pragma unroll
                    for (int m = 0; m < 4; ++m) { const f32x4 x = acc[ai][0][m][n] * s + bv; f32x4 o;
#pragma unroll
                        for (int j = 0; j < 4; ++j) o[j] = fminf(x[j], 0.f) - 0.6931471805599453f * __builtin_amdgcn_logf(1.0f + __builtin_amdgcn_exp2f(-1.4426950408889634f * fabsf(x[j])));
                        { const int mrow = row0 + ai * HALF + m * 16; float* lp = LF + ((size_t)((mrow >> 12) * 16 + 8 * fq + 4 * n) << 12) + (mrow & 4095);
#pragma unroll
                          for (int j = 0; j < 4; ++j) lp[(size_t)j << 12] = o[j]; } } }
        }
    }
};

typedef float xf2_t __attribute__((ext_vector_type(2)));
typedef _Float16 xh2_t __attribute__((ext_vector_type(2)));
__device__ __forceinline__ unsigned xpk(float lo, float hi) { const xf2_t v = {lo, hi}; const xh2_t h = __builtin_convertvector(v, xh2_t); return __builtin_bit_cast(unsigned, h); }
__device__ __forceinline__ float xlo(unsigned w) { return (float)__builtin_bit_cast(xh2_t, w)[0]; }
__device__ __forceinline__ float xhi(unsigned w) { return (float)__builtin_bit_cast(xh2_t, w)[1]; }
struct EpiResid {
    static constexpr bool PERM = true, AFTER_DRAIN = false;
    const bf16_t* base; bf16_t* out; const float* gate; int gstride; bf16_t* O; int mode; float s;
    __device__ __forceinline__ void operator()(const f32x4 (&acc)[2][2][4][2], const Unit& u, int wr, int wc, int fr, int fq) const {
        const int row0 = u.pm * BM + wr * 64 + fr, col0 = u.pn * BM + wc * 32 + 8 * fq;
        if (mode == 0) {
            const float* g = gate + (size_t)((u.pm * BM) >> 12) * gstride + col0;
            f32x4 gv[2][2];
#pragma unroll
            for (int bj = 0; bj < 2; ++bj)
#pragma unroll
                for (int n = 0; n < 2; ++n) gv[bj][n] = *(const f32x4*)(g + bj * HALF + 4 * n) * s;
#pragma unroll
            for (int ai = 0; ai < 2; ++ai)
#pragma unroll
                for (int m = 0; m < 4; ++m) { const size_t off = (size_t)(row0 + ai * HALF + m * 16) * 1024 + col0;
#pragma unroll
                    for (int bj = 0; bj < 2; ++bj) { const u32x4 bs = *(const u32x4*)(base + off + bj * HALF);
                        f32x4 x0 = {xlo(bs.x), xhi(bs.x), xlo(bs.y), xhi(bs.y)};
                        f32x4 x1 = {xlo(bs.z), xhi(bs.z), xlo(bs.w), xhi(bs.w)};
                        x0 = x0 + gv[bj][0] * acc[ai][bj][m][0]; x1 = x1 + gv[bj][1] * acc[ai][bj][m][1];
                        u32x4 w; w.x = xpk(x0[0], x0[1]); w.y = xpk(x0[2], x0[3]); w.z = xpk(x1[0], x1[1]); w.w = xpk(x1[2], x1[3]);
                        *(u32x4*)(out + off + bj * HALF) = w; }
                    asm volatile("" ::: "memory"); }
        } else {
#pragma unroll
            for (int ai = 0; ai < 2; ++ai)
#pragma unroll
                for (int m = 0; m < 4; ++m) { bf16_t* rowp = O + (size_t)(row0 + ai * HALF + m * 16) * 1024 + col0;
#pragma unroll
                    for (int bj = 0; bj < 2; ++bj) { const f32x4 v0 = acc[ai][bj][m][0], v1 = acc[ai][bj][m][1];
                        u32x4 w; w.x = cvt_pk_bf16(v0[0], v0[1]); w.y = cvt_pk_bf16(v0[2], v0[3]); w.z = cvt_pk_bf16(v1[0], v1[1]); w.w = cvt_pk_bf16(v1[2], v1[3]);
                        *(u32x4*)(rowp + bj * HALF) = w; } }
        }
    }
};

struct EpiSwiGLU {
    static constexpr bool PERM = true, AFTER_DRAIN = false;
    bf16_t* O; int ldc;
    __device__ __forceinline__ void operator()(const f32x4 (&acc)[2][2][4][2], const Unit& u, int wr, int wc, int fr, int fq) const {
        const int row0 = u.pm * BM + wr * 64 + fr, col0 = u.pn * HALF + wc * 32 + 8 * fq;
#pragma unroll
        for (int ai = 0; ai < 2; ++ai)
#pragma unroll
            for (int m = 0; m < 4; ++m) { bf16_t* rowp = O + (size_t)(row0 + ai * HALF + m * 16) * ldc + col0;
                const f32x4 g0 = acc[ai][0][m][0], g1 = acc[ai][0][m][1], u0 = acc[ai][1][m][0], u1 = acc[ai][1][m][1];
                const f32x4 h0 = g0 * sigmoid4(g0) * u0, h1 = g1 * sigmoid4(g1) * u1;
                u32x4 w; w.x = cvt_pk_bf16(h0[0], h0[1]); w.y = cvt_pk_bf16(h0[2], h0[3]); w.z = cvt_pk_bf16(h1[0], h1[1]); w.w = cvt_pk_bf16(h1[2], h1[3]);
                *(u32x4*)rowp = w; }
    }
};

struct EpiSwiGLU8 {
    static constexpr bool PERM = true, AFTER_DRAIN = false;
    unsigned char* O; int ldc; float s;
    __device__ __forceinline__ void operator()(const f32x4 (&acc)[2][2][4][2], const Unit& u, int wr, int wc, int fr, int fq) const {
        const int row0 = u.pm * BM + wr * 64 + fr, col0 = u.pn * HALF + wc * 32 + 8 * fq;
#pragma unroll
        for (int ai = 0; ai < 2; ++ai)
        { u32x2 w[4];
#pragma unroll
            for (int m = 0; m < 4; ++m) {
                const f32x4 g0 = acc[ai][0][m][0] * s, g1 = acc[ai][0][m][1] * s, u0 = acc[ai][1][m][0] * s, u1 = acc[ai][1][m][1] * s;
                const f32x4 h0 = g0 * sigmoid4(g0) * u0, h1 = g1 * sigmoid4(g1) * u1;
                w[m].x = pk_fp8x4(h0[0], h0[1], h0[2], h0[3]); w[m].y = pk_fp8x4(h1[0], h1[1], h1[2], h1[3]); }
#pragma unroll
            for (int k = 0; k < 2; ++k) { unsigned ax = w[k].x, bx = w[2 + k].x, ay = w[k].y, by = w[2 + k].y;
                asm volatile("v_permlane16_swap_b32 %0, %1" : "+v"(ax), "+v"(bx)); asm volatile("v_permlane16_swap_b32 %0, %1" : "+v"(ay), "+v"(by));
                u32x4 o; o.x = ax; o.y = ay; o.z = bx; o.w = by;
                *(u32x4*)(O + (size_t)(row0 + ai * HALF + (k + 2 * (fq & 1)) * 16) * ldc + (col0 - 8 * (fq & 1))) = o; } }
    }
};
struct EpiBf16S {
    static constexpr bool PERM = true, AFTER_DRAIN = false;
    bf16_t* O; float s;
    __device__ __forceinline__ void operator()(const f32x4 (&acc)[2][2][4][2], const Unit& u, int wr, int wc, int fr, int fq) const {
        const int row0 = u.pm * BM + wr * 64 + fr, col0 = u.pn * BM + wc * 32 + 8 * fq;
#pragma unroll
        for (int ai = 0; ai < 2; ++ai)
#pragma unroll
            for (int m = 0; m < 4; ++m) { bf16_t* rowp = O + (size_t)(row0 + ai * HALF + m * 16) * 1024 + col0;
#pragma unroll
                for (int bj = 0; bj < 2; ++bj) { const f32x4 v0 = acc[ai][bj][m][0] * s, v1 = acc[ai][bj][m][1] * s;
                    u32x4 w; w.x = cvt_pk_bf16(v0[0], v0[1]); w.y = cvt_pk_bf16(v0[2], v0[3]); w.z = cvt_pk_bf16(v1[0], v1[1]); w.w = cvt_pk_bf16(v1[2], v1[3]);
                    *(u32x4*)(rowp + bj * HALF) = w; } }
    }
};

typedef int v8i32 __attribute__((ext_vector_type(8))); typedef int v4i32 __attribute__((ext_vector_type(4)));
__device__ __forceinline__ void mfma_f8(f32x4& c, v8i32 a, v8i32 b) { asm volatile("v_mfma_f32_16x16x128_f8f6f4 %0, %1, %2, %0" : "+v"(c) : "v"(a), "v"(b)); }
__device__ __forceinline__ v8i32 cat32(bf16x8 a, bf16x8 b) { return __builtin_shufflevector(__builtin_bit_cast(v4i32, a), __builtin_bit_cast(v4i32, b), 0, 1, 2, 3, 4, 5, 6, 7); }
template <class Epi, class Sched, bool ALIGN_EPI = false, bool SP2 = false, bool F8 = false>
__device__ __forceinline__ void gemm_phase(PG8_LAS unsigned char* lds, const Gemm g, const Sched& S, const Epi& E, const int tid) {
    const int wid = __builtin_amdgcn_readfirstlane(tid >> 6), lane = tid & 63, wr = wid >> 2, wc = wid & 3, fr = lane & 15, fq = lane >> 4;
    const int K = g.K, nt = K / BK;
    unsigned voffA[2], voffB[2];
#pragma unroll
    for (int i = 0; i < 2; ++i) { int R, C; stage_rc(tid * 16 + i * 8192, R, C); const int Rb = Epi::PERM ? ((R & ~31) + perm32(R & 31)) : R;
        voffA[i] = (unsigned)(R * K + C) * 2u; voffB[i] = (unsigned)(Rb * K + C) * 2u; }
    const size_t kstep = (size_t)(BK * 2);
    const size_t hstep = (size_t)HALF * K * 2;
    const size_t tstep = 2 * hstep;
    const unsigned ldsw = (unsigned)wid * 1024u;
    const int aoff = lds_byte(wr * 64 + fr, fq * 8), boff = lds_byte(wc * 32 + fr, fq * 8);
#define PG8_SA(b, h) (((b) * 2 + (h)) * HTB)
#define PG8_SB(b, h) ((4 + (b) * 2 + (h)) * HTB)
#define PG8_STAGE(bufoff, gbase, voff) do { _Pragma("unroll") for (int _i = 0; _i < 2; ++_i) \
        __builtin_amdgcn_global_load_lds((const unsigned*)((const char*)(gbase) + (voff)[_i]), (PG8_LAS unsigned*)(lds + (bufoff) + ldsw + _i * 8192), 16, 0, 0); } while (0)
#define PG8_LDA(dst, b, h) do { _Pragma("unroll") for (int m = 0; m < 4; ++m) _Pragma("unroll") for (int k = 0; k < 2; ++k) dst[m][k] = *(const PG8_LAS bf16x8*)(lds + PG8_SA(b, h) + aoff + m * 2048 + k * 1024); } while (0)
#define PG8_LDB(dst, b, h) do { _Pragma("unroll") for (int n = 0; n < 2; ++n) _Pragma("unroll") for (int k = 0; k < 2; ++k) dst[n][k] = *(const PG8_LAS bf16x8*)(lds + PG8_SB(b, h) + boff + n * 2048 + k * 1024); } while (0)
#define PG8_MMA(ai, bj, At, Bt) do { __builtin_amdgcn_s_setprio(1); _Pragma("unroll") for (int m = 0; m < 4; ++m) _Pragma("unroll") for (int n = 0; n < 2; ++n) { \
        if constexpr (F8) mfma_f8(acc[ai][bj][m][n], cat32(Bt[n][0], Bt[n][1]), cat32(At[m][0], At[m][1])); \
        else { _Pragma("unroll") for (int k = 0; k < 2; ++k) acc[ai][bj][m][n] = __builtin_amdgcn_mfma_f32_16x16x32_bf16(Bt[n][k], At[m][k], acc[ai][bj][m][n], 0, 0, 0); } } __builtin_amdgcn_s_setprio(0); } while (0)
#define PG8_WAIT_V(n) asm volatile("s_waitcnt vmcnt(" #n ")" ::: "memory")
#define PG8_WAIT_L(n) asm volatile("s_waitcnt lgkmcnt(" #n ")" ::: "memory")
#define PG8_BAR __builtin_amdgcn_s_barrier()
#define PG8_SCHED __builtin_amdgcn_sched_barrier(0)
    Unit cur, nxt; int ui = 0;
    if (!S.next(0, cur)) return;
    f32x4 acc[2][2][4][2];
#pragma unroll
    for (int a = 0; a < 2; ++a)
#pragma unroll
        for (int b = 0; b < 2; ++b)
#pragma unroll
            for (int m = 0; m < 4; ++m)
#pragma unroll
                for (int n = 0; n < 2; ++n) acc[a][b][m][n] = (f32x4){0.f, 0.f, 0.f, 0.f};
    bf16x8 At[4][2], B0[2][2], B1[2][2];
    const char* cA = (const char*)g.A + (size_t)cur.pm * tstep; const char* cB = (const char*)g.Bt + (size_t)cur.pb * tstep;
    S.a_ready(cur);
    if constexpr (SP2) {
        PG8_STAGE(PG8_SB(0, 0), cB, voffB); PG8_STAGE(PG8_SB(0, 1), cB + hstep, voffB); PG8_STAGE(PG8_SA(0, 0), cA, voffA); PG8_STAGE(PG8_SA(0, 1), cA + hstep, voffA);
        if (wr == 1) PG8_BAR;
        PG8_WAIT_V(2); PG8_BAR;
        PG8_STAGE(PG8_SB(1, 0), cB + kstep, voffB); PG8_STAGE(PG8_SA(1, 0), cA + kstep, voffA); PG8_STAGE(PG8_SB(1, 1), cB + hstep + kstep, voffB);
        PG8_WAIT_V(6); PG8_BAR;
    } else {
        PG8_STAGE(PG8_SB(0, 0), cB, voffB); PG8_STAGE(PG8_SA(0, 0), cA, voffA); PG8_STAGE(PG8_SB(0, 1), cB + hstep, voffB); PG8_STAGE(PG8_SA(0, 1), cA + hstep, voffA);
        if (wr == 1) PG8_BAR;
        PG8_WAIT_V(4); PG8_BAR;
        PG8_STAGE(PG8_SB(1, 0), cB + kstep, voffB); PG8_STAGE(PG8_SA(1, 0), cA + kstep, voffA); PG8_STAGE(PG8_SB(1, 1), cB + hstep + kstep, voffB);
        PG8_WAIT_V(6); PG8_BAR;
    }
    for (;;) {
        const bool has_next = S.next(ui + 1, nxt);
        const char* nA = has_next ? (const char*)g.A + (size_t)nxt.pm * tstep : cA; const char* nB = has_next ? (const char*)g.Bt + (size_t)nxt.pb * tstep : cB;
        for (int t = 0; t < nt; t += 2) {
            const bool last = (t == nt - 2);
            const char* a1 = cA + (size_t)(t + 1) * kstep;
            const char* a2 = last ? nA : cA + (size_t)(t + 2) * kstep; const char* b2 = last ? nB : cB + (size_t)(t + 2) * kstep;
            const char* a3 = a2 + kstep; const char* b3 = b2 + kstep;
            if (last && has_next) S.a_ready(nxt);
            if constexpr (SP2) {
            PG8_LDB(B0, 0, 0); PG8_LDB(B1, 0, 1); PG8_SCHED; PG8_LDA(At, 0, 0); PG8_STAGE(PG8_SA(1, 1), a1 + hstep, voffA);
            PG8_WAIT_V(8); PG8_WAIT_L(0); PG8_BAR; PG8_MMA(0, 0, At, B0); PG8_MMA(0, 1, At, B1); PG8_BAR; PG8_SCHED;
            PG8_LDA(At, 0, 1); PG8_STAGE(PG8_SB(0, 0), b2, voffB); PG8_STAGE(PG8_SB(0, 1), b2 + hstep, voffB); PG8_STAGE(PG8_SA(0, 0), a2, voffA);
            PG8_WAIT_V(8); PG8_WAIT_L(0); PG8_BAR; PG8_MMA(1, 0, At, B0); PG8_MMA(1, 1, At, B1); PG8_BAR; PG8_SCHED;
            PG8_LDB(B0, 1, 0); PG8_LDB(B1, 1, 1); PG8_SCHED; PG8_LDA(At, 1, 0); PG8_STAGE(PG8_SA(0, 1), a2 + hstep, voffA);
            PG8_WAIT_V(8); PG8_WAIT_L(0); PG8_BAR; PG8_MMA(0, 0, At, B0); PG8_MMA(0, 1, At, B1); PG8_BAR; PG8_SCHED;
            PG8_LDA(At, 1, 1); PG8_STAGE(PG8_SB(1, 0), b3, voffB); PG8_STAGE(PG8_SB(1, 1), b3 + hstep, voffB); PG8_STAGE(PG8_SA(1, 0), a3, voffA);
            PG8_WAIT_V(8); PG8_WAIT_L(0); PG8_BAR; PG8_MMA(1, 0, At, B0); PG8_MMA(1, 1, At, B1); PG8_BAR; PG8_SCHED;
            } else {
            PG8_LDB(B0, 0, 0); PG8_SCHED; PG8_LDA(At, 0, 0); PG8_STAGE(PG8_SA(1, 1), a1 + hstep, voffA);
            PG8_WAIT_L(8); PG8_BAR; PG8_WAIT_L(0); PG8_MMA(0, 0, At, B0); PG8_BAR; PG8_SCHED;
            PG8_LDB(B1, 0, 1); PG8_STAGE(PG8_SB(0, 0), b2, voffB);
            PG8_BAR; PG8_WAIT_L(0); PG8_MMA(0, 1, At, B1); PG8_BAR;
            PG8_LDA(At, 0, 1); PG8_STAGE(PG8_SA(0, 0), a2, voffA);
            PG8_BAR; PG8_WAIT_L(0); PG8_MMA(1, 0, At, B0); PG8_BAR; PG8_SCHED;
            PG8_STAGE(PG8_SB(0, 1), b2 + hstep, voffB);
            PG8_WAIT_V(6); PG8_BAR; PG8_MMA(1, 1, At, B1); PG8_BAR;
            PG8_LDB(B0, 1, 0); PG8_SCHED; PG8_LDA(At, 1, 0); PG8_STAGE(PG8_SA(0, 1), a2 + hstep, voffA);
            PG8_WAIT_L(8); PG8_BAR; PG8_WAIT_L(0); PG8_MMA(0, 0, At, B0); PG8_BAR; PG8_SCHED;
            PG8_LDB(B1, 1, 1); PG8_STAGE(PG8_SB(1, 0), b3, voffB);
            PG8_BAR; PG8_WAIT_L(0); PG8_MMA(0, 1, At, B1); PG8_BAR;
            PG8_LDA(At, 1, 1); PG8_STAGE(PG8_SA(1, 0), a3, voffA);
            PG8_BAR; PG8_WAIT_L(0); PG8_MMA(1, 0, At, B0); PG8_BAR; PG8_SCHED;
            PG8_STAGE(PG8_SB(1, 1), b3 + hstep, voffB);
            PG8_WAIT_V(6); PG8_BAR; PG8_MMA(1, 1, At, B1); PG8_BAR;
            }
        }
        if constexpr (F8) asm volatile("s_nop 15\n\ts_nop 15\n\ts_nop 15\n\ts_nop 15" ::: "memory");
        if constexpr (ALIGN_EPI) { if (wr == 0) PG8_BAR; }
        if constexpr (!Epi::AFTER_DRAIN) { E(acc, cur, wr, wc, fr, fq); S.done(cur); }
        if (!has_next) break;
#pragma unroll
        for (int a = 0; a < 2; ++a)
#pragma unroll
            for (int b = 0; b < 2; ++b)
#pragma unroll
                for (int m = 0; m < 4; ++m)
#pragma unroll
                    for (int n = 0; n < 2; ++n) acc[a][b][m][n] = (f32x4){0.f, 0.f, 0.f, 0.f};
        cur = nxt; cA = nA; cB = nB; ++ui;
        if constexpr (ALIGN_EPI) { if (wr == 1) PG8_BAR; }
    }
    PG8_WAIT_V(0);
    if constexpr (!ALIGN_EPI) { if (wr == 0) PG8_BAR; }
    PG8_BAR;
    if constexpr (Epi::AFTER_DRAIN) { E.fused(acc, cur, wr, wc, fr, fq, lds, wid, lane); S.done(cur); }
#undef PG8_SA
#undef PG8_SB
#undef PG8_STAGE
#undef PG8_LDA
#undef PG8_LDB
#undef PG8_MMA
#undef PG8_WAIT_V
#undef PG8_WAIT_L
#undef PG8_BAR
#undef PG8_SCHED
}
}

#ifndef PG8_SP2
#define PG8_SP2 true
#endif
#ifndef PG8_ALIGN
#define PG8_ALIGN true
#endif
#include <hip/hip_bf16.h>
#include <cmath>
namespace attn_body {
using bf16=__hip_bfloat16;
using bf16x8=__attribute__((ext_vector_type(8)))short;
using s16x4=__attribute__((ext_vector_type(4)))short;
using f32x16=__attribute__((ext_vector_type(16)))float;
using u32x4=__attribute__((ext_vector_type(4)))unsigned;
using f32x4_t=__attribute__((ext_vector_type(4)))float;
constexpr int BATCH=8,NHEAD=16,SEQ=4096,D=64,DM=NHEAD*D;
constexpr int NW=8,QBLK=32,QB=QBLK*NW,KVBLK=64,NQB=SEQ/QB;
constexpr int ATTN_PITCH=DM, ATTN_UNIT_ROWS=QB;
__device__ __forceinline__ int crow(int r,int hi){return (r&3)+8*(r>>2)+4*hi;}
#define SBAR() __builtin_amdgcn_sched_barrier(0)
__device__ __forceinline__ void cmask(f32x16&p0,f32x16&p1,int jb,int qrel,int hi){
  const float NEG=-INFINITY; int kb=64*jb+4*hi;
  #pragma unroll
  for(int r=0;r<16;++r){int kv=kb+(r&3)+8*(r>>2); if(kv>qrel)p0[r]=NEG; if(kv+32>qrel)p1[r]=NEG;}
}

constexpr int NSLOT=3, SLOTB=8192;
constexpr int LDS_K=0, LDS_V=NSLOT*SLOTB, LDS_WS=2*NSLOT*SLOTB, LDS_OST=LDS_WS+NW*64*4, LDS_F=LDS_OST+NW*4096, LDS_BYTES=LDS_F+2048;
constexpr float C2=0.125f*1.4426950408889634f;
__device__ __forceinline__ void glds16(const void*gsrc,unsigned lds_dst){unsigned keep;
  asm volatile("s_mov_b32 %0, m0\n\ts_mov_b32 m0, %2\n\ts_nop 0\n\tglobal_load_lds_dwordx4 %1, off\n\ts_mov_b32 m0, %0":"=&s"(keep):"v"(gsrc),"s"(lds_dst):"memory");}
__device__ __forceinline__ void glds16s(unsigned voff,const void*sbase,unsigned lds_dst){unsigned keep;
  asm volatile("s_nop 4\n\ts_mov_b32 %0, m0\n\ts_mov_b32 m0, %3\n\ts_nop 0\n\tglobal_load_lds_dwordx4 %1, %2\n\ts_mov_b32 m0, %0":"=&s"(keep):"v"(voff),"s"(sbase),"s"(lds_dst):"memory");}
__device__ __forceinline__ void glds4s(unsigned voff,const void*sbase,unsigned lds_dst){unsigned keep;
  asm volatile("s_nop 4\n\ts_mov_b32 %0, m0\n\ts_mov_b32 m0, %3\n\ts_nop 0\n\tglobal_load_lds_dword %1, %2\n\ts_mov_b32 m0, %0":"=&s"(keep):"v"(voff),"s"(sbase),"s"(lds_dst):"memory");}
__device__ __forceinline__ void glds4(const void*gsrc,unsigned lds_dst){unsigned keep;
  asm volatile("s_mov_b32 %0, m0\n\ts_mov_b32 m0, %2\n\ts_nop 0\n\tglobal_load_lds_dword %1, off\n\ts_mov_b32 m0, %0":"=&s"(keep):"v"(gsrc),"s"(lds_dst):"memory");}
__device__ __forceinline__ float max3f(float a,float b,float c){float r;asm("v_max3_f32 %0, %1, %2, %3":"=v"(r):"v"(a),"v"(b),"v"(c));return r;}
__device__ __forceinline__ float max2f(float a,float b){float r;asm("v_max_f32_e32 %0, %1, %2":"=v"(r):"v"(a),"v"(b));return r;}
__device__ __forceinline__ float fadd_s(float a,float b){float r;asm("v_add_f32_e32 %0, %1, %2":"=v"(r):"v"(a),"v"(b));return r;}
__device__ __forceinline__ float fsub_s(float a,float b){float r;asm("v_sub_f32_e32 %0, %1, %2":"=v"(r):"v"(a),"v"(b));return r;}
typedef float f32x2_t __attribute__((ext_vector_type(2))); typedef __bf16 bf16x2_t __attribute__((ext_vector_type(2)));
__device__ __forceinline__ unsigned cvtpk_s(float lo,float hi){f32x2_t v={lo,hi};bf16x2_t b=__builtin_convertvector(v,bf16x2_t);return __builtin_bit_cast(unsigned,b);}
#define WAIT_BAR(N) asm volatile("s_waitcnt vmcnt(" #N ") lgkmcnt(0)\n\ts_barrier":::"memory")

__device__ __forceinline__ bf16x8 make_qx(float m,int hi){
  const unsigned h0=cvtpk_s(m,0.f)&0xffffu; const float r1=m-__uint_as_float(h0<<16);
  const unsigned h1=cvtpk_s(r1,0.f)&0xffffu; const float r2=r1-__uint_as_float(h1<<16);
  const unsigned h2=cvtpk_s(r2,0.f)&0xffffu;
  u32x4 w; w.x=0x3F803F80u; w.y=0x3F80u|(h0<<16); w.z=h1|(h2<<16); w.w=0u;
  if(hi){w.x=0u;w.y=0u;w.z=0u;}
  return __builtin_bit_cast(bf16x8,w);
}
__device__ __forceinline__ void qkt(f32x16&p0,f32x16&p1,const char*Kslot,const bf16x8*qr,const f32x16&negm,int r32,int hi,int xoff_,bf16x8 qx){
  const char*kb=Kslot+hi*1024+r32*16;
  #pragma unroll
  for(int d0=0;d0<4;++d0){
    const bf16x8 b0=*reinterpret_cast<const bf16x8*>(kb+d0*2048);
    const bf16x8 b1=*reinterpret_cast<const bf16x8*>(kb+d0*2048+512);
    if(d0==0){p0=__builtin_amdgcn_mfma_f32_32x32x16_bf16(b0,qr[0],negm,0,0,0);p1=__builtin_amdgcn_mfma_f32_32x32x16_bf16(b1,qr[0],negm,0,0,0);}
    else{p0=__builtin_amdgcn_mfma_f32_32x32x16_bf16(b0,qr[d0],p0,0,0,0);p1=__builtin_amdgcn_mfma_f32_32x32x16_bf16(b1,qr[d0],p1,0,0,0);}}
  const char*xb=Kslot+xoff_+r32*16;
  p0=__builtin_amdgcn_mfma_f32_32x32x16_bf16(*reinterpret_cast<const bf16x8*>(xb),qx,p0,0,0,0);p1=__builtin_amdgcn_mfma_f32_32x32x16_bf16(*reinterpret_cast<const bf16x8*>(xb+512),qx,p1,0,0,0);
}
typedef __attribute__((address_space(3))) const char* lds_cptr;
typedef short v4i16_t __attribute__((ext_vector_type(4)));
__device__ __forceinline__ void kload8(bf16x8*kf,lds_cptr kp){
  kf[0]=*(const __attribute__((address_space(3))) bf16x8*)(kp);      kf[1]=*(const __attribute__((address_space(3))) bf16x8*)(kp+512);
  kf[2]=*(const __attribute__((address_space(3))) bf16x8*)(kp+2048); kf[3]=*(const __attribute__((address_space(3))) bf16x8*)(kp+2560);
  kf[4]=*(const __attribute__((address_space(3))) bf16x8*)(kp+4096); kf[5]=*(const __attribute__((address_space(3))) bf16x8*)(kp+4608);
  kf[6]=*(const __attribute__((address_space(3))) bf16x8*)(kp+6144); kf[7]=*(const __attribute__((address_space(3))) bf16x8*)(kp+6656);
}
__device__ __forceinline__ void kload2(bf16x8*kf,lds_cptr kp,int j){ kf[2*j]=*(const __attribute__((address_space(3))) bf16x8*)(kp+j*2048); kf[2*j+1]=*(const __attribute__((address_space(3))) bf16x8*)(kp+j*2048+512); }
__device__ __forceinline__ s16x4 vtr(lds_cptr p){ return __builtin_bit_cast(s16x4,__builtin_amdgcn_ds_read_tr16_b64_v4i16((__attribute__((address_space(3))) v4i16_t*)p)); }
__device__ __forceinline__ float rowmax(const f32x16&p0,const f32x16&p1){
  float a=max3f(p0[0],p0[1],p1[0]),b=max3f(p0[2],p0[3],p1[1]);a=max3f(a,p1[2],p1[3]);
  #pragma unroll
  for(int r=4;r<16;r+=4){a=max3f(a,p0[r],p0[r+1]);b=max3f(b,p0[r+2],p0[r+3]);a=max3f(a,p1[r],p1[r+1]);b=max3f(b,p1[r+2],p1[r+3]);}
  const float m=max2f(a,b);
  auto rr=__builtin_amdgcn_permlane32_swap(__float_as_uint(m),__float_as_uint(m),false,false);
  return max2f(__uint_as_float(rr[0]),__uint_as_float(rr[1]));
}
__device__ __forceinline__ void pv(f32x16*o,int vb,bf16x8 pa0,bf16x8 pa1,bf16x8 pa2,bf16x8 pa3){
  #pragma unroll
  for(int d0=0;d0<2;++d0){s16x4 lo[4],hi[4];
    #pragma unroll
    for(int ks=0;ks<4;++ks){
      asm volatile("ds_read_b64_tr_b16 %0,%1 offset:%c2":"=&v"(lo[ks]):"v"(vb),"i"(d0*4096+ks*1024):"memory");
      asm volatile("ds_read_b64_tr_b16 %0,%1 offset:%c2":"=&v"(hi[ks]):"v"(vb),"i"(d0*4096+ks*1024+512):"memory");}
    asm volatile("s_waitcnt lgkmcnt(0)":::"memory");SBAR();
    #define PK(k) (bf16x8){lo[k][0],lo[k][1],lo[k][2],lo[k][3],hi[k][0],hi[k][1],hi[k][2],hi[k][3]}
    o[d0]=__builtin_amdgcn_mfma_f32_32x32x16_bf16(pa0,PK(0),o[d0],0,0,0);
    o[d0]=__builtin_amdgcn_mfma_f32_32x32x16_bf16(pa1,PK(1),o[d0],0,0,0);
    o[d0]=__builtin_amdgcn_mfma_f32_32x32x16_bf16(pa2,PK(2),o[d0],0,0,0);
    o[d0]=__builtin_amdgcn_mfma_f32_32x32x16_bf16(pa3,PK(3),o[d0],0,0,0);
    #undef PK
  }
}

#ifndef ATTN_STORE16
#define ATTN_STORE16(p,v) (*(u32x4*)(p)=(v))
#endif
template<int THRL> __device__ __forceinline__ void attn_unit(int b,int h,int qb,const bf16*Q,const bf16*__restrict__ K,const bf16*__restrict__ V,bf16*O,const float*__restrict__ Fh,const bf16*__restrict__ KXh,char*shm,const int tid){
  const int lane=tid&63,r32=lane&31,hi=lane>>5; const int wid=__builtin_amdgcn_readfirstlane(tid>>6);
  const long rowbase=(long)b*SEQ; const int q0=qb*QB;
  const bf16*Qw=Q+(rowbase+q0+wid*QBLK)*DM+h*D;
  const bf16*Kh=K+rowbase*DM+h*D,*Vh=V+rowbase*DM+h*D;
  const unsigned lds0=(unsigned)(uintptr_t)shm;
  float*wsf=(float*)(shm+LDS_WS)+wid*64;
  const unsigned koff=(unsigned)(lane*DM+wid*8)*2u;
  const unsigned voffv=(unsigned)((16*(wid&3)+(lane>>2))*DM+(wid>>2)*32+(lane&3)*8)*2u;
  const unsigned kdst=lds0+LDS_K+wid*1024, vdst=lds0+LDS_V+wid*1024;
  #define DMA_K(t,slot) glds16s(koff,Kh+(long)(t)*KVBLK*DM,(unsigned)__builtin_amdgcn_readfirstlane(kdst+(slot)))
  #define DMA_V(t,slot) glds16s(voffv,Vh+(long)(t)*KVBLK*DM,(unsigned)__builtin_amdgcn_readfirstlane(vdst+(slot)))
  const unsigned xdst=lds0+LDS_F+(wid&3)*256; const unsigned xoff=(unsigned)(lane*4+(wid&3)*256);
  #define DMA_KX(t) glds4s(xoff,(const char*)KXh+(long)(t)*1024,(unsigned)__builtin_amdgcn_readfirstlane(xdst+(((t)&1)*1024)))
  const lds_cptr xp0=(lds_cptr)shm+LDS_F+r32*16;
  #define KXRD(t) do{ kx0=*(const __attribute__((address_space(3))) bf16x8*)(xp0+(((t)&1)*1024)); kx1=*(const __attribute__((address_space(3))) bf16x8*)(xp0+(((t)&1)*1024)+512); }while(0)
  const int vb0=(int)(lds0+LDS_V)+((lane>>4)&1)*32+(lane&3)*8+(4*hi+((lane&15)>>2))*64;
  const char*Kbase=shm+LDS_K; bf16x8 kf[8];
  const lds_cptr shm3=(lds_cptr)shm; const lds_cptr kp0=shm3+LDS_K+hi*1024+r32*16; const lds_cptr vp0=shm3+LDS_V+((lane>>4)&1)*32+(lane&3)*8+(4*hi+((lane&15)>>2))*64;
  const int NT=(q0+QB)/KVBLK;
  DMA_KX(0);DMA_KX(1);DMA_K(0,0);DMA_V(0,0);DMA_K(1,SLOTB);
  bf16x8 qr[4];
  #pragma unroll
  for(int d0=0;d0<4;++d0)qr[d0]=*reinterpret_cast<const bf16x8*>(&Qw[(long)r32*DM+d0*16+hi*8]);
  const float fq0=Fh[q0+wid*QBLK+r32];
  float dg=0.f;
  { const bf16*Kd=Kh+(long)(q0+wid*QBLK+r32)*DM+hi*8;
    #pragma unroll
    for(int d0=0;d0<4;++d0){ const u32x4 kw=*reinterpret_cast<const u32x4*>(Kd+d0*16); const u32x4 qw=__builtin_bit_cast(u32x4,qr[d0]);
      #pragma unroll
      for(int j=0;j<4;++j){ dg+=__uint_as_float(kw[j]<<16)*__uint_as_float(qw[j]<<16); dg+=__uint_as_float(kw[j]&0xffff0000u)*__uint_as_float(qw[j]&0xffff0000u); } }
    auto rr=__builtin_amdgcn_permlane32_swap(__float_as_uint(dg),__float_as_uint(dg),false,false); dg=__uint_as_float(rr[0])+__uint_as_float(rr[1]); }
  float mhat=dg-fq0,l_reg=0.f;f32x16 o[2];o[0]=f32x16{};o[1]=f32x16{};const f32x16 negm=f32x16{};
  bf16x8 kx0,kx1;
  #define QXNOW() ({ float m_=mhat; asm volatile("":"+v"(m_)); make_qx(m_,hi); })
  const int qrel=wid*QBLK+r32;
  #define CMASK(P0,P1,t) do{int jb_=(t)-(NT-4); if(jb_>=0)cmask(P0,P1,jb_,qrel,hi);}while(0)
  bool resc=false;
  #define START(P0,P1) do{ const float rm=rowmax(P0,P1); resc=false; \
    { const float dl=max2f(rm,0.f); mhat=fadd_s(mhat,dl); \
      _Pragma("unroll") for(int r=0;r<16;++r){P0[r]=fsub_s(P0[r],dl);P1[r]=fsub_s(P1[r],dl);} \
      } \
    _Pragma("unroll") for(int r=0;r<16;++r)P0[r]=__builtin_amdgcn_exp2f(P0[r]); }while(0)
  #define RESC() do{ if(resc){ asm volatile("s_waitcnt lgkmcnt(0)":::"memory"); \
      _Pragma("unroll") for(int d_=0;d_<2;++d_) _Pragma("unroll") for(int r=0;r<16;++r)o[d_][r]*=wsf[crow(r,hi)]; } }while(0)
  f32x16 pA0,pA1,pB0,pB1;
  int sl_prev=0,sl_cur=0,sl_next=SLOTB;
  #define ROT() do{sl_prev=sl_cur;sl_cur=sl_next;sl_next=(sl_next==(NSLOT-1)*SLOTB)?0:sl_next+SLOTB;}while(0)
  DMA_K(2,2*SLOTB);
  WAIT_BAR(3);
  qkt(pA0,pA1,Kbase,qr,negm,r32,hi,LDS_F-LDS_K,QXNOW());asm volatile("s_nop 15\n\ts_nop 7":"+v"(pA0),"+v"(pA1));CMASK(pA0,pA1,0);
  START(pA0,pA1);
  _Pragma("unroll") for(int r=0;r<16;++r)pA1[r]=__builtin_amdgcn_exp2f(pA1[r]);
  WAIT_BAR(0);
  DMA_K(3,0);DMA_V(1,SLOTB);
  ROT();
  kload8(kf,kp0+sl_cur);
  WAIT_BAR(2);
  s16x4 vlo[8],vhi[8]; u32x4 pw0,pw1,pw2,pw3;
  #define PKW(P,B) cvtpk_s(P[B],P[B+1])
  #define PAF(k) __builtin_bit_cast(bf16x8,pw##k)
  #define VFR(i) (bf16x8){vlo[i][0],vlo[i][1],vlo[i][2],vlo[i][3],vhi[i][0],vhi[i][1],vhi[i][2],vhi[i][3]}
  #define PIN(x) asm volatile("":"+v"(x))
  #define MX3(a,b,c) __builtin_fmaxf(__builtin_fmaxf((a),(b)),(c))
  #define GAPA(MF,A0,A1,A2,A3,W0,W1,PW) do{ MF; sacc+=A0; sacc+=A1; sacc+=A2; sacc+=A3; PIN(sacc); W0; W1; PIN(PW); SBAR(); }while(0)
  #define EX(v) __builtin_amdgcn_exp2f(v)
  #define GAPB(MF,X,B) do{ MF; X[B]=EX(X[B]); X[B+1]=EX(X[B+1]); X[B+2]=EX(X[B+2]); X[B+3]=EX(X[B+3]); PIN(X); SBAR(); }while(0)
  #define VRD(i) do{ vlo[i]=vtr(vp_+(((i)>>2)*4096+((i)&3)*1024)); vhi[i]=vtr(vp_+(((i)>>2)*4096+((i)&3)*1024+512)); }while(0)
  #define KRD(G,j) do{ if(G){ kload2(kf,kp0+sl_next,j); SBAR(); } }while(0)
  #define STEP(C0,C1,P0,P1,t,GK,GV,GL) do{ SBAR(); if(GV){DMA_KX((t)+1);} \
    const lds_cptr vp_=vp0+sl_prev; \
    float sacc=(P0[0]+P0[1]); \
    GAPA(C0=__builtin_amdgcn_mfma_f32_32x32x16_bf16(kf[0],qr[0],negm,0,0,0), P0[2],P0[3],P0[4],P0[5],     pw0[0]=PKW(P0,0), pw0[1]=PKW(P0,2), pw0); \
    GAPA(C1=__builtin_amdgcn_mfma_f32_32x32x16_bf16(kf[1],qr[0],negm,0,0,0), P0[6],P0[7],P0[8],P0[9],     pw0[2]=PKW(P0,4), pw0[3]=PKW(P0,6), pw0); \
    GAPA(C0=__builtin_amdgcn_mfma_f32_32x32x16_bf16(kf[2],qr[1],C0,0,0,0),   P0[10],P0[11],P0[12],P0[13], pw1[0]=PKW(P0,8), pw1[1]=PKW(P0,10), pw1); \
    GAPA(C1=__builtin_amdgcn_mfma_f32_32x32x16_bf16(kf[3],qr[1],C1,0,0,0),   P0[14],P0[15],P1[0],P1[1],   pw1[2]=PKW(P0,12),pw1[3]=PKW(P0,14), pw1); \
    KXRD(t); const bf16x8 qx=QXNOW(); SBAR(); \
    GAPA(C0=__builtin_amdgcn_mfma_f32_32x32x16_bf16(kf[4],qr[2],C0,0,0,0),   P1[2],P1[3],P1[4],P1[5],     pw2[0]=PKW(P1,0), pw2[1]=PKW(P1,2), pw2); \
    GAPA(C1=__builtin_amdgcn_mfma_f32_32x32x16_bf16(kf[5],qr[2],C1,0,0,0),   P1[6],P1[7],P1[8],P1[9],     pw2[2]=PKW(P1,4), pw2[3]=PKW(P1,6), pw2); \
    GAPA(C0=__builtin_amdgcn_mfma_f32_32x32x16_bf16(kf[6],qr[3],C0,0,0,0),   P1[10],P1[11],P1[12],P1[13], pw3[0]=PKW(P1,8), pw3[1]=PKW(P1,10), pw3); \
    GAPA(C1=__builtin_amdgcn_mfma_f32_32x32x16_bf16(kf[7],qr[3],C1,0,0,0),   P1[14],P1[15],0.f,0.f,       pw3[2]=PKW(P1,12),pw3[3]=PKW(P1,14), pw3); \
    C0=__builtin_amdgcn_mfma_f32_32x32x16_bf16(kx0,qx,C0,0,0,0); SBAR(); C1=__builtin_amdgcn_mfma_f32_32x32x16_bf16(kx1,qx,C1,0,0,0); SBAR(); \
    l_reg+=sacc; \
    if(GK){DMA_K((t)+3,sl_cur);} if(GV){DMA_V((t)+1,sl_next);} \
    CMASK(C0,C1,t); \
    { float a=MX3(C0[0],C0[1],C1[0]),b=MX3(C0[2],C0[3],C1[1]); a=MX3(a,C1[2],C1[3]); \
      _Pragma("unroll") for(int r=4;r<16;r+=4){a=MX3(a,C0[r],C0[r+1]);b=MX3(b,C0[r+2],C0[r+3]);a=MX3(a,C1[r],C1[r+1]);b=MX3(b,C1[r+2],C1[r+3]);} \
      float rm=__builtin_fmaxf(a,b); { auto rr=__builtin_amdgcn_permlane32_swap(__float_as_uint(rm),__float_as_uint(rm),false,false); rm=__builtin_fmaxf(__uint_as_float(rr[0]),__uint_as_float(rr[1])); } \
      resc=false; \
      if(__builtin_expect(__any(rm>(float)THRL),0)){ const float dl=__builtin_fmaxf(rm,0.f); mhat+=dl; \
        _Pragma("unroll") for(int r=0;r<16;++r){C0[r]-=dl;C1[r]-=dl;} \
        const float f=__builtin_amdgcn_exp2f(-dl); l_reg*=f; if(hi==0)wsf[r32]=f; resc=true; } } \
    SBAR(); \
    VRD(0); VRD(4); SBAR(); VRD(1); SBAR(); GAPB(o[0]=__builtin_amdgcn_mfma_f32_32x32x16_bf16(PAF(0),VFR(0),o[0],0,0,0), C0,0); \
    VRD(5); SBAR(); GAPB(o[1]=__builtin_amdgcn_mfma_f32_32x32x16_bf16(PAF(0),VFR(4),o[1],0,0,0), C0,4); \
    KRD(GL,0); VRD(2); SBAR(); GAPB(o[0]=__builtin_amdgcn_mfma_f32_32x32x16_bf16(PAF(1),VFR(1),o[0],0,0,0), C0,8); \
    KRD(GL,1); VRD(6); SBAR(); GAPB(o[1]=__builtin_amdgcn_mfma_f32_32x32x16_bf16(PAF(1),VFR(5),o[1],0,0,0), C0,12); \
    KRD(GL,2); VRD(3); SBAR(); GAPB(o[0]=__builtin_amdgcn_mfma_f32_32x32x16_bf16(PAF(2),VFR(2),o[0],0,0,0), C1,0); \
    KRD(GL,3); VRD(7); SBAR(); GAPB(o[1]=__builtin_amdgcn_mfma_f32_32x32x16_bf16(PAF(2),VFR(6),o[1],0,0,0), C1,4); \
    GAPB(o[0]=__builtin_amdgcn_mfma_f32_32x32x16_bf16(PAF(3),VFR(3),o[0],0,0,0), C1,8); \
    GAPB(o[1]=__builtin_amdgcn_mfma_f32_32x32x16_bf16(PAF(3),VFR(7),o[1],0,0,0), C1,12); \
    }while(0)
  int t=1;
  #undef CMASK
  #define CMASK(P0,P1,t) do{}while(0)
  for(;t+5<NT;t+=2){
    STEP(pB0,pB1,pA0,pA1,t,true,true,true);     WAIT_BAR(2); RESC(); ROT();
    STEP(pA0,pA1,pB0,pB1,t+1,true,true,true);   WAIT_BAR(2); RESC(); ROT();
  }
  #undef CMASK
  #define CMASK(P0,P1,t) do{int jb_=(t)-(NT-4); if(jb_>=0)cmask(P0,P1,jb_,qrel,hi);}while(0)
  #define ENDW(tt) do{ if((tt)+3<NT){WAIT_BAR(2);} else if((tt)+2<NT){WAIT_BAR(1);} else {WAIT_BAR(0);} }while(0)
  for(;t+1<NT;t+=2){
    STEP(pB0,pB1,pA0,pA1,t,(t+3<NT),(t+1<NT),(t+1<NT));       ENDW(t);   RESC(); ROT();
    STEP(pA0,pA1,pB0,pB1,t+1,(t+4<NT),(t+2<NT),(t+2<NT));     ENDW(t+1); RESC(); ROT();
  }
  STEP(pB0,pB1,pA0,pA1,NT-1,false,false,false); RESC();
  { float sacc=pB0[0]+pB0[1]; _Pragma("unroll") for(int r=2;r<16;++r)sacc+=pB0[r]; _Pragma("unroll") for(int r=0;r<16;++r)sacc+=pB1[r]; l_reg+=sacc;
    pw0=(u32x4){PKW(pB0,0),PKW(pB0,2),PKW(pB0,4),PKW(pB0,6)};pw1=(u32x4){PKW(pB0,8),PKW(pB0,10),PKW(pB0,12),PKW(pB0,14)};pw2=(u32x4){PKW(pB1,0),PKW(pB1,2),PKW(pB1,4),PKW(pB1,6)};pw3=(u32x4){PKW(pB1,8),PKW(pB1,10),PKW(pB1,12),PKW(pB1,14)};
    SBAR(); pv(o,vb0+sl_cur,PAF(0),PAF(1),PAF(2),PAF(3)); }
  #undef PKW
  #undef PAF
  #undef VFR
  #undef PIN
  #undef MX3
  #undef GAPA
  #undef GAPB
  #undef EX
  #undef VRD
  #undef KRD
  #undef STEP
  #undef ENDW
  {auto rr=__builtin_amdgcn_permlane32_swap(__float_as_uint(l_reg),__float_as_uint(l_reg),false,false);l_reg=__uint_as_float(rr[0])+__uint_as_float(rr[1]);}
  if(hi==0)wsf[32+r32]=l_reg;asm volatile("s_waitcnt lgkmcnt(0)":::"memory");
  float rli[16];
  #pragma unroll
  for(int r=0;r<16;++r)rli[r]=__builtin_amdgcn_rcpf(wsf[32+crow(r,hi)]);
  bf16*Ow=O+(rowbase+q0+wid*QBLK)*DM+h*D;
  { bf16*stg=(bf16*)(shm+LDS_OST)+wid*2048;
    #pragma unroll
    for(int r=0;r<16;++r){const int orow=crow(r,hi);
      #pragma unroll
      for(int d0=0;d0<2;++d0)stg[orow*64+d0*32+r32]=__float2bfloat16(o[d0][r]*rli[r]);}
    asm volatile("s_waitcnt lgkmcnt(0)":::"memory");
    #pragma unroll
    for(int i=0;i<4;++i){const int row=i*8+(lane>>3),ch=lane&7; const u32x4 v=*(const u32x4*)(stg+row*64+ch*8); ATTN_STORE16(Ow+(long)row*DM+ch*8,v);} }
  asm volatile("s_waitcnt lgkmcnt(0)\n\ts_barrier":::"memory");
  #undef DMA_K
  #undef DMA_V
  #undef DMA_KX
  #undef KXRD
  #undef QXNOW
  #undef CMASK
  #undef START
  #undef RESC
  #undef ROT
}
constexpr int ATTN_LDS_BYTES=LDS_BYTES;
struct AttnTensors { const bf16* Q; const bf16* K; const bf16* V; bf16* O; const float* F; const bf16* KX; };
struct AttnUnit { int bh; int qb; };
struct StaticOrder {
  int vcu,G;
  __device__ __forceinline__ explicit StaticOrder(int grid,int v):vcu(v),G(grid){}
  __device__ __forceinline__ bool next(int i,AttnUnit&u)const{
    if(G==256){ if(i>=8)return false; const int s=(vcu&1)*4+(i>>1); u.bh=vcu>>1; u.qb=(i&1)?15-s:s; return true; }
    const int L=i*G+vcu; if(L>=BATCH*NHEAD*NQB)return false; u.bh=L/NQB; u.qb=L%NQB; return true; }
  __device__ __forceinline__ void a_ready(const AttnUnit&)const{}
  __device__ __forceinline__ void done(const AttnUnit&)const{}
};
template<class Sched,int THRL=8> __device__ __forceinline__ void attn_phase(char*lds,const AttnTensors&T,const Sched&S,const int tid){
  AttnUnit u;
  for(int i=0;S.next(i,u);++i){ S.a_ready(u); attn_unit<THRL>(u.bh/NHEAD,u.bh%NHEAD,u.qb,T.Q,T.K,T.V,T.O,T.F+(long)u.bh*SEQ,T.KX+(long)u.bh*SEQ*8,lds,tid); S.done(u); }
}
#undef SBAR
#undef WAIT_BAR
}
#define GAS __attribute__((address_space(1)))
#define LAS __attribute__((address_space(3)))
typedef unsigned short bf16;
typedef unsigned v4u __attribute__((ext_vector_type(4)));
typedef float f32x4 __attribute__((ext_vector_type(4)));
typedef short bf16x8 __attribute__((ext_vector_type(8)));
typedef GAS unsigned gu32;
typedef GAS unsigned long long gu64;
#define RLX_AGENT __ATOMIC_RELAXED, __HIP_MEMORY_SCOPE_AGENT
#define LDS_WAIT() asm volatile("s_waitcnt lgkmcnt(0)" ::: "memory")
#define VM_WAIT() asm volatile("s_waitcnt vmcnt(0)" ::: "memory")
__device__ __forceinline__ unsigned long long rt() { return __builtin_amdgcn_s_memrealtime(); }
typedef float f32x2_t __attribute__((ext_vector_type(2))); typedef __bf16 bf16x2_t __attribute__((ext_vector_type(2)));
__device__ __forceinline__ unsigned pk2(float lo, float hi) { f32x2_t v = {lo, hi}; bf16x2_t b = __builtin_convertvector(v, bf16x2_t); return __builtin_bit_cast(unsigned, b); }
__device__ __forceinline__ unsigned f2bf(float f) { return pk2(f, 0.f) & 0xffffu; }

#define XB_TMO      128
#define XB_XCNT(j)  (256  + 64 * (j))
#define XB_XSUB(j)  (1280 + 64 * (j))
#define XB_XGEN(j)  (2304 + 64 * (j))
#define XB_TOP      3328
#define XB_TOPGEN   3392
#define XCD_BAR_WORDS 3456
#define XB_SPIN_CAP (1u << 18)

__device__ __forceinline__ unsigned xb_ld(unsigned* p)              { return __hip_atomic_load(p, __ATOMIC_RELAXED, __HIP_MEMORY_SCOPE_AGENT); }
__device__ __forceinline__ unsigned xb_add(unsigned* p, unsigned v) { return __hip_atomic_fetch_add(p, v, __ATOMIC_RELAXED, __HIP_MEMORY_SCOPE_AGENT); }
__device__ __forceinline__ unsigned xb_xcc_id() { return (unsigned)__builtin_amdgcn_s_getreg((3 << 11) | 20) & 0xFu; }
#define XB_SPIN(cond, bar) do { unsigned _sp = 0; while (cond) { __builtin_amdgcn_s_sleep(1); \
    if ((++_sp & 255u) == 0u) { if (xb_ld(&(bar)[XB_TMO])) break; if (_sp > XB_SPIN_CAP) { atomicAdd(&(bar)[XB_TMO], 1u); break; } } } } while (0)

struct XcdBarrier {
    unsigned* bar; unsigned x;
    volatile LAS unsigned* st;
};

__device__ __forceinline__ XcdBarrier xcd_barrier_post(unsigned* bar, volatile LAS unsigned* st) {
    XcdBarrier b; b.bar = bar; b.x = xb_xcc_id(); b.st = st;
    if (threadIdx.x == 0) (void)xb_add(&bar[XB_XCNT(b.x)], 1u);
    return b;
}
__device__ __forceinline__ void xcd_barrier_complete(unsigned* bar, unsigned x, unsigned& nloc, unsigned& nx) {
    const unsigned G = gridDim.x * gridDim.y * gridDim.z;
    unsigned sum, cnt, mine, sp = 0u;
    for (;;) {
        sum = 0u; cnt = 0u; mine = 0u;
#pragma unroll
        for (unsigned j = 0; j < 16; ++j) { const unsigned c = xb_ld(&bar[XB_XCNT(j)]); sum += c; cnt += (c > 0u) ? 1u : 0u; mine = (j == x) ? c : mine; }
        if (sum == G) break;
        __builtin_amdgcn_s_sleep(1);
        if ((++sp & 255u) == 0u) { if (xb_ld(&bar[XB_TMO])) break; if (sp > XB_SPIN_CAP) { atomicAdd(&bar[XB_TMO], 1u); break; } }
    }
    nloc = mine > 0u ? mine : 1u; nx = cnt > 0u ? cnt : 1u;
}

__device__ __forceinline__ void xcd_barrier(const XcdBarrier& b) {
    asm volatile("s_waitcnt vmcnt(0)" ::: "memory");
    __syncthreads();
    int t0_ = threadIdx.x; asm volatile("" : "+v"(t0_));
    if (t0_ == 0) {
        unsigned* bar = b.bar;
        __builtin_amdgcn_s_waitcnt(0);
        unsigned nloc = b.st[0], nx = b.st[1];
        if (nloc == 0u) { xcd_barrier_complete(bar, b.x, nloc, nx); b.st[0] = nloc; b.st[1] = nx; }
        const unsigned old = xb_add(&bar[XB_XSUB(b.x)], 1u);
        const unsigned gen = old / nloc;
        if (old + 1u == (gen + 1u) * nloc) {
            __builtin_amdgcn_fence(__ATOMIC_RELEASE, "agent");
            asm volatile("s_waitcnt vmcnt(0)" ::: "memory");
            const unsigned og = xb_add(&bar[XB_TOP], 1u);
            const unsigned tg = og / nx;
            if (og + 1u == (tg + 1u) * nx) xb_add(&bar[XB_TOPGEN], 1u);
            else XB_SPIN(xb_ld(&bar[XB_TOPGEN]) == tg, bar);
            __builtin_amdgcn_fence(__ATOMIC_ACQUIRE, "agent");
            xb_add(&bar[XB_XGEN(b.x)], 1u);
            asm volatile("s_waitcnt vmcnt(0)" ::: "memory");
        } else {
            XB_SPIN(xb_ld(&bar[XB_XGEN(b.x)]) == gen, bar);
            __builtin_amdgcn_fence(__ATOMIC_ACQUIRE, "agent");
            asm volatile("s_waitcnt vmcnt(0)" ::: "memory");
        }
    }
    __syncthreads();
}


constexpr int NWAVES = 8;
constexpr int BATCH = 8, SEQ = 4096, D = 1024, NTOK = BATCH * SEQ;
constexpr int DEPTH = 4, D_IN = 9232, D_INP = 9472;
constexpr int DFF = 2816, NEXP = 8, DFE = 3584, NADA = 6, ADAW = NADA * D;
constexpr int NQ = 128;
constexpr float EPS = 1e-6f;
constexpr float LOG2E = 1.4426950408889634f;
constexpr int MOE_TILES_MAX = 264;

constexpr size_t MiB = 1u << 20;
constexpr size_t WS_CTL = 0, CTL_ZERO_BYTES = 1 * MiB;
constexpr size_t WS_ADAP16 = 16 * MiB;
constexpr size_t WS_ADAP = 1 * MiB;
constexpr size_t WS_ADA = 4 * MiB;
constexpr size_t WS_LB = 4 * MiB + 800 * 1024;
constexpr size_t WS_LF = 5 * MiB;
constexpr size_t WS_F = 7 * MiB;
constexpr size_t WS_DL = 9 * MiB;
constexpr size_t WS_DSC = 13 * MiB;
constexpr size_t WS_ROUTE = 13 * MiB + 512 * 1024;
constexpr size_t WS_U = 16 * MiB;
constexpr size_t WS_XB = 48 * MiB;
constexpr size_t WS_WIN = 117 * MiB;
constexpr size_t WS_WOUT = 154 * MiB;
constexpr size_t WS_WGU = 162 * MiB;
constexpr size_t WS_WDN = 184 * MiB;
constexpr size_t WS_XN = 196 * MiB;
constexpr size_t WS_ACT = 260 * MiB;
constexpr size_t ACTB = 64 * MiB;
constexpr size_t WS_INTER_D = WS_ACT;
constexpr size_t WS_INTER_M = 196 * MiB;
constexpr size_t WS_WMGU = 664 * MiB;
constexpr size_t WS_WMDN = 776 * MiB;
constexpr size_t WS_HS = 832 * MiB;
constexpr size_t WS_QF = 964 * MiB, WS_KF = 1028 * MiB;
constexpr size_t WS_KX = 1092 * MiB;
constexpr size_t WS_WIN8 = 1100 * MiB;
constexpr size_t WS_XN8 = 964 * MiB;
constexpr size_t WS_END = 1100 * MiB;
static_assert(WS_U + (size_t)512 * 4 * 64 * 64 * 4 <= WS_XB && WS_XB + (size_t)NTOK * D * 2 <= WS_WIN && WS_WIN + (size_t)4 * D_INP * D <= WS_WOUT, "d_ws map (x, in-projection weights)");
static_assert(WS_INTER_M + (size_t)MOE_TILES_MAX * 256 * DFE * 2 <= WS_WMGU && WS_HS + (size_t)MOE_TILES_MAX * 256 * D * 2 <= WS_END && WS_ACT + 11 * ACTB == WS_QF && WS_XN8 == WS_QF && WS_KF + ACTB == WS_KX, "d_ws map");
constexpr int CW_TMO = 0, CW_CODE = 1;
constexpr int CW_BAR = 4096;
constexpr int CW_CNT = 16384;

constexpr int RING_OFF = 0, RING_BYTES = 131072;
constexpr int LDSCTL_OFF = RING_BYTES, MISC_OFF = LDSCTL_OFF + 320, PTAB_OFF = LDSCTL_OFF + 1024;
constexpr int HGT_OFF = LDSCTL_OFF + 2048, HGT_PITCH = 272, HGT_BYTES = 32 * HGT_PITCH;
constexpr int LDS_BYTES = 151552;
static_assert(HGT_OFF + 2 * HGT_BYTES <= LDS_BYTES && LDS_BYTES <= 163840, "LDS map (hg tiles)");
static_assert(MISC_OFF + 128 <= LDS_BYTES, "LDS map");

struct Frame {
    LAS unsigned char* lds;
    volatile LAS unsigned* MISC;
    gu32* ctl;
    int tid, lane, wave, vcu, G;
    unsigned char* ws;
};

__device__ __forceinline__ float shfl_idx(float v, int src_lane) { return __int_as_float(__builtin_amdgcn_ds_bpermute(src_lane << 2, __float_as_int(v))); }
__device__ __forceinline__ float wave_sum(float v, int lane) {
#pragma unroll
    for (int o = 1; o < 64; o <<= 1) v += shfl_idx(v, lane ^ o);
    return v;
}
__device__ __forceinline__ float bf2f(unsigned short h) { return __uint_as_float((unsigned)h << 16); }
__device__ __forceinline__ float bflo(unsigned w) { return __uint_as_float(w << 16); }
__device__ __forceinline__ float bfhi(unsigned w) { return __uint_as_float(w & 0xffff0000u); }
__device__ __forceinline__ float sigmoidf_(float v) { return 1.0f / (1.0f + __expf(-v)); }

struct TrDesc { const float* src; bf16* dst; int ldn, nvalid, K; unsigned char* dst8; float scale; };
__device__ __forceinline__ TrDesc tr_desc(const float* W, int ldn, int s0, int nvalid, int k0, bf16* WT, int K, int d0) { TrDesc t; t.src = W + (size_t)k0 * ldn + s0; t.dst = WT + (size_t)d0 * K + k0; t.ldn = ldn; t.nvalid = nvalid; t.K = K; t.dst8 = nullptr; t.scale = 1.0f; return t; }
__device__ __forceinline__ TrDesc tr_desc8(const float* W, int ldn, int s0, int k0, unsigned char* WT8, int K, int d0, float scale, int nvalid = 32) { TrDesc t; t.src = W + (size_t)k0 * ldn + s0; t.dst = nullptr; t.ldn = ldn; t.nvalid = nvalid; t.K = K; t.dst8 = WT8 + (size_t)d0 * K + k0; t.scale = scale; return t; }
__device__ __forceinline__ void tr_load(const TrDesc& t, float (&v)[32], int lane) {
    const int n = lane & 31; const bool ok = n < (t.nvalid & 63); const int nn = (t.nvalid & 64) ? 16 * (n >> 3) + (n & 7) : n;
    const float* p = t.src + (size_t)(lane >> 5) * t.ldn + (ok ? nn : 0);
#pragma unroll
    for (int i = 0; i < 32; ++i) { const float x = p[(size_t)(2 * i) * t.ldn]; v[i] = ok ? x : 0.f; }
}
__device__ __forceinline__ void tr_store(const TrDesc& t, const float (&v)[32], LAS float* scr, int lane) {
#pragma unroll
    for (int i = 0; i < 32; ++i) scr[(2 * i + (lane >> 5)) * 33 + (lane & 31)] = v[i];
    LDS_WAIT(); asm volatile("" ::: "memory");
    const int c = lane & 7;
    if (t.dst8 != nullptr) {
        const float sc = t.scale;
#pragma unroll
        for (int j = 0; j < 4; ++j) { const int n = (lane >> 3) + 8 * j; const LAS float* s = scr + (8 * c) * 33 + n;
            pg8::u32x2 o; o.x = pg8::pk_fp8x4(s[0 * 33] * sc, s[1 * 33] * sc, s[2 * 33] * sc, s[3 * 33] * sc); o.y = pg8::pk_fp8x4(s[4 * 33] * sc, s[5 * 33] * sc, s[6 * 33] * sc, s[7 * 33] * sc);
            *(GAS pg8::u32x2*)(t.dst8 + (size_t)n * t.K + 8 * c) = o; }
    } else {
#pragma unroll
    for (int j = 0; j < 4; ++j) { const int n = (lane >> 3) + 8 * j; const LAS float* s = scr + (8 * c) * 33 + n;
        v4u o; o.x = pk2(s[0 * 33], s[1 * 33]); o.y = pk2(s[2 * 33], s[3 * 33]); o.z = pk2(s[4 * 33], s[5 * 33]); o.w = pk2(s[6 * 33], s[7 * 33]);
        *(GAS v4u*)(t.dst + (size_t)n * t.K + 8 * c) = o; }
    }
    LDS_WAIT(); asm volatile("" ::: "memory");
}
__device__ __forceinline__ TrDesc tr_gateup(const float* Wg, const float* Wu, int dff, int r, bf16* WT) {
    const int nblk = 2 * dff / 32, kb = r / nblk, db = r % nblk, p = db >> 3, q = db & 7;
    return tr_desc(q < 4 ? Wg : Wu, dff, 128 * p + 32 * (q & 3), 32, 64 * kb, WT, D, 32 * db);
}
__device__ __forceinline__ TrDesc tr_plain(const float* W, int K, int N, int r, bf16* WT) {
    const int nblk = N / 32, kb = r / nblk, db = r % nblk;
    return tr_desc(W, N, 32 * db, 32, 64 * kb, WT, K, 32 * db);
}
#define TR_LOOP(NIT_, DESC) do { float va_[32], vb_[32]; TrDesc da_, db_; int it_ = gw; if (it_ < (NIT_)) { da_ = DESC(it_); tr_load(da_, va_, F.lane); } \
    while (it_ < (NIT_)) { const int i1_ = it_ + NGW, i2_ = it_ + 2 * NGW; \
        if (i1_ < (NIT_)) { db_ = DESC(i1_); tr_load(db_, vb_, F.lane); } tr_store(da_, va_, scr, F.lane); \
        if (i1_ >= (NIT_)) break; \
        if (i2_ < (NIT_)) { da_ = DESC(i2_); tr_load(da_, va_, F.lane); } tr_store(db_, vb_, scr, F.lane); it_ = i2_; } } while (0)

enum InIdx { IN_X = 0, IN_C, IN_WADA, IN_BADA, IN_NMIX, IN_NFFN, IN_WIN, IN_QG, IN_KG, IN_FB, IN_LB, IN_OG, IN_WOUT, IN_WR, IN_BR, IN_DG, IN_DU, IN_DD, IN_MG, IN_MU, IN_MD, IN_OUT };
__device__ __forceinline__ float* gptr(const Frame& F, int k) {
    const LAS unsigned* t = (const LAS unsigned*)(F.lds + PTAB_OFF) + 2 * k; const unsigned lo = __builtin_amdgcn_readfirstlane(t[0]), hi = __builtin_amdgcn_readfirstlane(t[1]);
    return (float*)(GAS float*)(((unsigned long long)hi << 32) | lo); }

__device__ __forceinline__ void p0_prologue(Frame& F) {
    LAS float* scr = (LAS float*)(F.lds + RING_OFF + F.wave * 16384);
    const int gw = F.vcu * NWAVES + F.wave, NGW = F.G * NWAVES;
    {
        LAS float* cs = (LAS float*)(F.lds + RING_OFF + 8 * 16384 - 32768);
        const float* cp_ = gptr(F, IN_C);
        for (int i = F.tid; i < 8192; i += NWAVES * 64) { const int b = i >> 10, k = i & 1023; const float v = cp_[i]; cs[k * 8 + b] = v * sigmoidf_(v); }
        __syncthreads();
        float* P = (float*)(F.ws + WS_ADAP16);
        for (int it = F.wave * F.G + F.vcu; it < 4 * 24 * 16; it += NGW) {
            const int l = it / 384, r = it % 384, nb = r >> 4, ks = r & 15;
            f32x4 acc[8];
#pragma unroll
            for (int b = 0; b < 8; ++b) acc[b] = (f32x4){0.f, 0.f, 0.f, 0.f};
            const float* wp = gptr(F, IN_WADA) + ((size_t)l * D + ks * 64) * ADAW + nb * 256 + F.lane * 4;
#pragma unroll
            for (int kb = 0; kb < 2; ++kb) { f32x4 w[32];
#pragma unroll
                for (int k = 0; k < 32; ++k) w[k] = *(const f32x4*)(wp + (size_t)(kb * 32 + k) * ADAW);
#pragma unroll
                for (int k = 0; k < 32; ++k) { const int kk = ks * 64 + kb * 32 + k;
                    const f32x4 c0 = *(const LAS f32x4*)(cs + kk * 8), c1 = *(const LAS f32x4*)(cs + kk * 8 + 4);
                    acc[0] += c0[0] * w[k]; acc[1] += c0[1] * w[k]; acc[2] += c0[2] * w[k]; acc[3] += c0[3] * w[k]; acc[4] += c1[0] * w[k]; acc[5] += c1[1] * w[k]; acc[6] += c1[2] * w[k]; acc[7] += c1[3] * w[k]; } }
#pragma unroll
            for (int b = 0; b < 8; ++b) *(f32x4*)(P + ((size_t)(ks * 4 + l) * 8 + b) * ADAW + nb * 256 + F.lane * 4) = acc[b];
        }
        __syncthreads();
    }
    for (int c = gw * 64 + F.lane; c < 1024; c += NGW * 64) {
        const float* lbi = gptr(F, IN_LB); const float a0 = lbi[c], a1 = lbi[1024 + c], a2 = lbi[2048 + c], a3 = lbi[3072 + c];
        const float mx = fmaxf(fmaxf(a0, a1), fmaxf(a2, a3));
        const float e0 = expf(a0 - mx), e1 = expf(a1 - mx), e2 = expf(a2 - mx), e3 = expf(a3 - mx), inv = 1.0f / (e0 + e1 + e2 + e3);
        float* lb = (float*)(F.ws + WS_LB);
        lb[c] = 0.f; lb[1024 + c] = e1 * inv; lb[2048 + c] = (e1 + e2) * inv; lb[3072 + c] = (e1 + e2 + e3) * inv;
    }
    constexpr int I_IN = 16 * (D_INP / 32), I_OUT = 16 * 32, I_GU = 16 * (2 * DFF / 32), I_DN = (DFF / 64) * 32;
    constexpr int NIT = 4 * (I_IN + I_OUT) + 2 * (I_GU + I_DN);
    auto desc = [&](int it) -> TrDesc {
        int r = it;
        if (r < 4 * I_IN) { const int l = r / I_IN; r -= l * I_IN; const int kb = r / (D_INP / 32), db = r % (D_INP / 32);
            int s0, nv; if (db < 64) { s0 = 256 * (db >> 3) + 64 * (db & 3) + 32 * ((db >> 2) & 1); nv = 32; }
            else if (db < 96) { s0 = 32 * db; nv = 32; } else if (db < 160) { s0 = 256 * (db >> 3) + 16 + 64 * (db & 3) + 8 * ((db >> 2) & 1); nv = 32 | 64; }
            else if (db < 224) { s0 = 32 * db + 16; nv = 32; } else if (db < 288) { s0 = 256 * (db >> 3) + 16 + 64 * (db & 3) + 8 * ((db >> 2) & 1); nv = 32 | 64; }   else if (db == 288) { s0 = 3072; nv = 16; } else { s0 = 0; nv = 0; }
            return tr_desc8(gptr(F, IN_WIN) + (size_t)l * D * D_IN, D_IN, s0, 64 * kb, F.ws + WS_WIN + (size_t)l * D_INP * D, D, 32 * db, 32.0f, nv);
            return tr_desc(gptr(F, IN_WIN) + (size_t)l * D * D_IN, D_IN, s0, nv, 64 * kb, (bf16*)(F.ws + WS_WIN) + (size_t)l * D_INP * D, D, 32 * db); }
        r -= 4 * I_IN;
        if (r < 4 * I_OUT) { const int l = r / I_OUT; r -= l * I_OUT; return tr_plain(gptr(F, IN_WOUT) + (size_t)l * D * D, D, D, r, (bf16*)(F.ws + WS_WOUT) + (size_t)l * D * D); }
        r -= 4 * I_OUT;
        if (r < 2 * I_GU) { const int i = r / I_GU; r -= i * I_GU; return tr_gateup(gptr(F, IN_DG) + (size_t)i * D * DFF, gptr(F, IN_DU) + (size_t)i * D * DFF, DFF, r, (bf16*)(F.ws + WS_WGU) + (size_t)i * 2 * DFF * D); }
        r -= 2 * I_GU;
        { const int i = r / I_DN; r -= i * I_DN; const int nblk = D / 32, kb = r / nblk, db = r % nblk;
            return tr_desc8(gptr(F, IN_DD) + (size_t)i * DFF * D, D, 32 * db, 64 * kb, F.ws + WS_WDN + (size_t)i * D * DFF, DFF, 32 * db, 64.0f); }
    };
    TR_LOOP(NIT, desc);
}
constexpr float MOE_WS_GU = 32.0f, MOE_WS_DN = 64.0f;
__device__ __forceinline__ void moe_weights(Frame& F, int i) {
    LAS float* scr = (LAS float*)(F.lds + RING_OFF + F.wave * 16384);
    const int gw = F.vcu * NWAVES + F.wave, NGW = F.G * NWAVES;
    constexpr int I_GU = 16 * (2 * DFE / 32), I_DN = (DFE / 64) * 32, PER = I_GU + I_DN;
    auto desc = [&](int it) -> TrDesc {
        const int e = it / PER; const int r = it % PER; const size_t we = (size_t)(i * NEXP + e) * D * DFE;
        if (r < I_GU) { const int nblk = 2 * DFE / 32, kb = r / nblk, db = r % nblk, p = db >> 3, q = db & 7;
            return tr_desc8((q < 4 ? gptr(F, IN_MG) : gptr(F, IN_MU)) + we, DFE, 128 * p + 32 * (q & 3), 64 * kb, F.ws + WS_WMGU + (size_t)e * 2 * DFE * D, D, 32 * db, MOE_WS_GU); }
        { const int r2 = r - I_GU, nblk = D / 32, kb = r2 / nblk, db = r2 % nblk;
            return tr_desc8(gptr(F, IN_MD) + we, D, 32 * db, 64 * kb, F.ws + WS_WMDN + (size_t)e * D * DFE, DFE, 32 * db, MOE_WS_DN); }
    };
    TR_LOOP(NEXP * PER, desc);
}
__device__ __forceinline__ void ada_final(Frame& F) {
    const float* P = (const float*)(F.ws + WS_ADAP16); float* A = (float*)(F.ws + WS_ADA);
    const int gt = F.vcu * NWAVES * 64 + F.tid, NT = F.G * NWAVES * 64;
    const float* bad = gptr(F, IN_BADA);
    for (int i = gt; i < 4 * 8 * ADAW; i += NT) { const int l = i / (8 * ADAW), n = i % ADAW;
        float a[4] = {0.f, 0.f, 0.f, 0.f};
#pragma unroll
        for (int ks = 0; ks < 16; ++ks) a[ks & 3] += P[(size_t)ks * 4 * 8 * ADAW + i];
        A[i] = bad[l * ADAW + n] + ((a[0] + a[1]) + (a[2] + a[3])); }
}

__device__ __forceinline__ void moe_offsets(const gu32* cnt, int (&off)[9], int (&n)[8]) {
    int o = 0;
#pragma unroll
    for (int e = 0; e < 8; ++e) { n[e] = (int)__hip_atomic_load(cnt + e * 64, RLX_AGENT); off[e] = o; o += (n[e] + 255) & ~255; }
    off[8] = o;
}

template <bool ROUTE, bool COMB> __device__ __forceinline__ void row_phase(Frame& F, bool first, int lprev, int do_norm, int l) {
    constexpr bool do_route = ROUTE, do_comb = COMB; constexpr int RB = (ROUTE || COMB) ? 4 : 8;
    float* const out = gptr(F, IN_OUT); const float* const src = (const float*)gptr(F, IN_X); bf16* const XB = (bf16*)(F.ws + WS_XB);
    const float* const ada = (const float*)(F.ws + WS_ADA);
    const int moe_prev = lprev >> 1, moe_i = l >> 1;
    const float* const g2prev = ada + (size_t)lprev * 8 * ADAW + 5 * D;
    const float* const gain = (do_norm == 2 ? gptr(F, IN_NFFN) : gptr(F, IN_NMIX)) + l * D;
    const float* const sc = ada + (size_t)l * 8 * ADAW + (do_norm == 2 ? 4 : 1) * D; const float* const sh = ada + (size_t)l * 8 * ADAW + (do_norm == 2 ? 3 : 0) * D;
    const int lane = F.lane;
    bf16* XN = (bf16*)(F.ws + WS_XN);
    const bf16* DB = (const bf16*)(F.ws + WS_HS);
    const v4u* route_r = (const v4u*)(F.ws + WS_ROUTE);
    int off[9], ncnt[8];
    if (do_comb) moe_offsets(F.ctl + CW_CNT + moe_prev * 8 * 64, off, ncnt);
    LAS unsigned* lcnt = (LAS unsigned*)(F.lds + RING_OFF); LAS unsigned* gbase = lcnt + 8; LAS unsigned* rec = lcnt + 16;
    LAS f32x4* wl = (LAS f32x4*)(F.lds + RING_OFF + 4096);
    float br[8];
    if (do_route) {
        const f32x4* wsrc = (const f32x4*)(gptr(F, IN_WR) + (size_t)moe_i * D * 8);
        for (int q = F.tid; q < 2048; q += NWAVES * 64) { const int c = q >> 1, half = q & 1, j = (c >> 2) & 3, i = c & 3, ln = c >> 4; wl[((j * 4 + i) * 2 + half) * 64 + ln] = wsrc[q]; }
#pragma unroll
        for (int e = 0; e < 8; ++e) br[e] = gptr(F, IN_BR)[moe_i * 8 + e];
        __syncthreads();
    }
    for (int blk = F.vcu; blk < NTOK / NQ; blk += F.G) {
        if (do_route) { if (F.tid < 8) lcnt[F.tid] = 0u; __syncthreads(); }
        const int b = (blk * NQ) >> 12;
        for (int jr0 = 0; jr0 < 16; jr0 += RB) {
            const int rl0 = F.wave * 16 + jr0, row0 = blk * NQ + rl0;
            f32x4 v[RB][4];
#pragma unroll
            for (int r = 0; r < RB; ++r) {
                if (first) { const GAS f32x4* xr = (const GAS f32x4*)(src + (size_t)(row0 + r) * D) + 4 * lane;
#pragma unroll
                    for (int j = 0; j < 4; ++j) v[r][j] = xr[j]; }
                else { const GAS pg8::u32x4* xr = (const GAS pg8::u32x4*)(XB + (size_t)(row0 + r) * D) + 2 * lane;
#pragma unroll
                    for (int jj = 0; jj < 2; ++jj) { const pg8::u32x4 t = xr[jj]; v[r][2 * jj] = (f32x4){pg8::xlo(t.x), pg8::xhi(t.x), pg8::xlo(t.y), pg8::xhi(t.y)}; v[r][2 * jj + 1] = (f32x4){pg8::xlo(t.z), pg8::xhi(t.z), pg8::xlo(t.w), pg8::xhi(t.w)}; } } }
            if (first) {
#pragma unroll
                for (int r = 0; r < RB; ++r) { GAS pg8::u32x4* xo = (GAS pg8::u32x4*)(XB + (size_t)(row0 + r) * D) + 2 * lane;
#pragma unroll
                    for (int jj = 0; jj < 2; ++jj) { pg8::u32x4 t; t.x = pg8::xpk(v[r][2 * jj].x, v[r][2 * jj].y); t.y = pg8::xpk(v[r][2 * jj].z, v[r][2 * jj].w); t.z = pg8::xpk(v[r][2 * jj + 1].x, v[r][2 * jj + 1].y); t.w = pg8::xpk(v[r][2 * jj + 1].z, v[r][2 * jj + 1].w); xo[jj] = t; } } }
            if (do_comb) {
                v4u rt[RB];
#pragma unroll
                for (int r = 0; r < RB; ++r) rt[r] = route_r[row0 + r];
                uint2 da[RB][4], dc[RB][4];
#pragma unroll
                for (int r = 0; r < RB; ++r) { const int e1 = rt[r].x & 0xff, e2 = (rt[r].x >> 8) & 0xff;
                    int o1 = 0, o2 = 0;
#pragma unroll
                    for (int e = 0; e < 8; ++e) { o1 = (e1 == e) ? off[e] : o1; o2 = (e2 == e) ? off[e] : o2; }
                    const size_t r1 = (size_t)o1 + rt[r].y, r2 = (size_t)o2 + rt[r].z;
                    const v4u* d1 = (const v4u*)(DB + r1 * D) + 2 * lane; const v4u* d2 = (const v4u*)(DB + r2 * D) + 2 * lane;
#pragma unroll
                    for (int jj = 0; jj < 2; ++jj) { const v4u a = d1[jj], c = d2[jj]; da[r][2 * jj].x = a.x; da[r][2 * jj].y = a.y; da[r][2 * jj + 1].x = a.z; da[r][2 * jj + 1].y = a.w;
                        dc[r][2 * jj].x = c.x; dc[r][2 * jj].y = c.y; dc[r][2 * jj + 1].x = c.z; dc[r][2 * jj + 1].y = c.w; } }
                const f32x4* gp = (const f32x4*)(g2prev + (size_t)b * ADAW) + 4 * lane;
                f32x4 g[4];
#pragma unroll
                for (int j = 0; j < 4; ++j) g[j] = gp[j];
#pragma unroll
                for (int r = 0; r < RB; ++r) { const float w1 = __uint_as_float(rt[r].w), w2 = 1.0f - w1;
#pragma unroll
                    for (int j = 0; j < 4; ++j) { const uint2 a = da[r][j], c = dc[r][j];
                        f32x4 m; m[0] = w1 * bflo(a.x) + w2 * bflo(c.x); m[1] = w1 * bfhi(a.x) + w2 * bfhi(c.x); m[2] = w1 * bflo(a.y) + w2 * bflo(c.y); m[3] = w1 * bfhi(a.y) + w2 * bfhi(c.y);
                        v[r][j] = v[r][j] + g[j] * m; }
                    if (do_norm == 0) { GAS f32x4* orow = (GAS f32x4*)(out + (size_t)(row0 + r) * D) + 4 * lane;
#pragma unroll
                        for (int j = 0; j < 4; ++j) orow[j] = v[r][j]; }
                    else { GAS pg8::u32x4* xo = (GAS pg8::u32x4*)(XB + (size_t)(row0 + r) * D) + 2 * lane;
#pragma unroll
                        for (int jj = 0; jj < 2; ++jj) { pg8::u32x4 t; t.x = pg8::xpk(v[r][2 * jj].x, v[r][2 * jj].y); t.y = pg8::xpk(v[r][2 * jj].z, v[r][2 * jj].w); t.z = pg8::xpk(v[r][2 * jj + 1].x, v[r][2 * jj + 1].y); t.w = pg8::xpk(v[r][2 * jj + 1].z, v[r][2 * jj + 1].w); xo[jj] = t; } } }
            }
            if (do_norm) {
                const f32x4* gp = (const f32x4*)gain + 4 * lane; const f32x4* scp = (const f32x4*)(sc + (size_t)b * ADAW) + 4 * lane; const f32x4* shp = (const f32x4*)(sh + (size_t)b * ADAW) + 4 * lane;
                f32x4 gg[4], tt[4];
#pragma unroll
                for (int j = 0; j < 4; ++j) { gg[j] = gp[j] * (1.0f + scp[j]); tt[j] = shp[j]; }
                float s2[RB];
#pragma unroll
                for (int r = 0; r < RB; ++r) { s2[r] = 0.f;
#pragma unroll
                    for (int j = 0; j < 4; ++j) s2[r] += (v[r][j].x * v[r][j].x + v[r][j].y * v[r][j].y) + (v[r][j].z * v[r][j].z + v[r][j].w * v[r][j].w); }
#pragma unroll
                for (int o = 1; o < 64; o <<= 1)
#pragma unroll
                    for (int r = 0; r < RB; ++r) s2[r] += shfl_idx(s2[r], lane ^ o);
#pragma unroll
                for (int r = 0; r < RB; ++r) {
                    const float rstd = 1.0f / sqrtf(s2[r] * (1.f / D) + EPS);
#pragma unroll
                    for (int j = 0; j < 4; ++j) v[r][j] = (v[r][j] * rstd) * gg[j] + tt[j];
                    if (do_norm != 1) { GAS pg8::u32x4* o16 = (GAS pg8::u32x4*)(XN + (size_t)(row0 + r) * D) + 2 * lane;
#pragma unroll
                        for (int jj = 0; jj < 2; ++jj) { pg8::u32x4 t; t.x = pk2(v[r][2 * jj].x, v[r][2 * jj].y); t.y = pk2(v[r][2 * jj].z, v[r][2 * jj].w); t.z = pk2(v[r][2 * jj + 1].x, v[r][2 * jj + 1].y); t.w = pk2(v[r][2 * jj + 1].z, v[r][2 * jj + 1].w); o16[jj] = t; } }
                    if (do_norm == 1) { pg8::u32x4 t;
                        t.x = pg8::pk_fp8x4(v[r][0].x, v[r][0].y, v[r][0].z, v[r][0].w); t.y = pg8::pk_fp8x4(v[r][1].x, v[r][1].y, v[r][1].z, v[r][1].w);
                        t.z = pg8::pk_fp8x4(v[r][2].x, v[r][2].y, v[r][2].z, v[r][2].w); t.w = pg8::pk_fp8x4(v[r][3].x, v[r][3].y, v[r][3].z, v[r][3].w);
                        *((GAS pg8::u32x4*)(F.ws + WS_XN8 + (size_t)(row0 + r) * D) + lane) = t; }
                }
                if (do_route) {
                    float lg[RB][8];
#pragma unroll
                    for (int r = 0; r < RB; ++r)
#pragma unroll
                        for (int e = 0; e < 8; ++e) lg[r][e] = 0.f;
#pragma unroll
                    for (int j = 0; j < 4; ++j)
#pragma unroll
                        for (int i = 0; i < 4; ++i) { const f32x4 w0 = wl[((j * 4 + i) * 2 + 0) * 64 + lane], w1 = wl[((j * 4 + i) * 2 + 1) * 64 + lane];
#pragma unroll
                            for (int r = 0; r < RB; ++r) { const float hv = v[r][j][i];
                                lg[r][0] += hv * w0[0]; lg[r][1] += hv * w0[1]; lg[r][2] += hv * w0[2]; lg[r][3] += hv * w0[3]; lg[r][4] += hv * w1[0]; lg[r][5] += hv * w1[1]; lg[r][6] += hv * w1[2]; lg[r][7] += hv * w1[3]; } }
#pragma unroll
                    for (int o = 1; o < 64; o <<= 1)
#pragma unroll
                        for (int r = 0; r < RB; ++r)
#pragma unroll
                            for (int e = 0; e < 8; ++e) lg[r][e] += shfl_idx(lg[r][e], lane ^ o);
#pragma unroll
                    for (int r = 0; r < RB; ++r) {
                        const int rl = rl0 + r;
#pragma unroll
                        for (int e = 0; e < 8; ++e) lg[r][e] += br[e];
                        int i1 = 0; float v1 = lg[r][0];
#pragma unroll
                        for (int e = 1; e < 8; ++e) if (lg[r][e] > v1) { v1 = lg[r][e]; i1 = e; }
                        int i2 = -1; float v2 = -INFINITY;
#pragma unroll
                        for (int e = 0; e < 8; ++e) if (e != i1 && lg[r][e] > v2) { v2 = lg[r][e]; i2 = e; }
                        const float w1 = 1.0f / (1.0f + expf(v2 - v1));
                        if (lane == 0) { const unsigned s1 = __hip_atomic_fetch_add(lcnt + i1, 1u, __ATOMIC_RELAXED, __HIP_MEMORY_SCOPE_WORKGROUP), s2_ = __hip_atomic_fetch_add(lcnt + i2, 1u, __ATOMIC_RELAXED, __HIP_MEMORY_SCOPE_WORKGROUP);
                            rec[rl * 4 + 0] = (unsigned)i1 | ((unsigned)i2 << 8); rec[rl * 4 + 1] = s1; rec[rl * 4 + 2] = s2_; rec[rl * 4 + 3] = __float_as_uint(w1); }
                    }
                }
            }
        }
        if (do_route) {
            __syncthreads();
            if (F.tid < 8) gbase[F.tid] = __hip_atomic_fetch_add(F.ctl + CW_CNT + (moe_i * 8 + F.tid) * 64, lcnt[F.tid], RLX_AGENT);
            __syncthreads();
            if (F.tid < NQ) { const unsigned ee = rec[F.tid * 4]; v4u o; o.x = ee; o.y = gbase[ee & 0xff] + rec[F.tid * 4 + 1]; o.z = gbase[(ee >> 8) & 0xff] + rec[F.tid * 4 + 2]; o.w = rec[F.tid * 4 + 3];
                *(GAS v4u*)((v4u*)(F.ws + WS_ROUTE) + blk * NQ + F.tid) = o; }
            __syncthreads();
        }
    }
}

__device__ __forceinline__ void moe_scatter(Frame& F, int moe_i) {
    const int gw = F.vcu * NWAVES + F.wave, NGW = F.G * NWAVES, lane = F.lane;
    int off[9], ncnt[8]; moe_offsets(F.ctl + CW_CNT + moe_i * 8 * 64, off, ncnt);
    const v4u* route_r = (const v4u*)(F.ws + WS_ROUTE); const v4u* XN = (const v4u*)(F.ws + WS_XN); v4u* HS = (v4u*)(F.ws + WS_HS);
    for (int row = gw; row < NTOK; row += NGW) {
        const v4u rt = route_r[row]; const int e1 = rt.x & 0xff, e2 = (rt.x >> 8) & 0xff; int o1 = 0, o2 = 0;
#pragma unroll
        for (int e = 0; e < 8; ++e) { o1 = (e1 == e) ? off[e] : o1; o2 = (e2 == e) ? off[e] : o2; }
        const size_t r1 = (size_t)o1 + rt.y, r2 = (size_t)o2 + rt.z;
        const v4u a = XN[(size_t)row * 128 + 2 * lane], c = XN[(size_t)row * 128 + 2 * lane + 1];
        v4u o; o.x = pg8::pk_fp8x4(bflo(a.x), bfhi(a.x), bflo(a.y), bfhi(a.y)); o.y = pg8::pk_fp8x4(bflo(a.z), bfhi(a.z), bflo(a.w), bfhi(a.w));
        o.z = pg8::pk_fp8x4(bflo(c.x), bfhi(c.x), bflo(c.y), bfhi(c.y)); o.w = pg8::pk_fp8x4(bflo(c.z), bfhi(c.z), bflo(c.w), bfhi(c.w));
        HS[r1 * 64 + lane] = o; HS[r2 * 64 + lane] = o;
    }
    int padstart[9]; padstart[0] = 0;
#pragma unroll
    for (int e = 0; e < 8; ++e) padstart[e + 1] = padstart[e] + (((ncnt[e] + 255) & ~255) - ncnt[e]);
    for (int p = gw; p < padstart[8]; p += NGW) {
        int row = 0;
#pragma unroll
        for (int e = 0; e < 8; ++e) if (p >= padstart[e] && p < padstart[e + 1]) row = off[e] + ncnt[e] + (p - padstart[e]);
        const v4u z = (v4u){0u, 0u, 0u, 0u}; HS[(size_t)row * 64 + lane] = z;
    }
}

__host__ __device__ __forceinline__ unsigned hg_offb(unsigned row, unsigned ch) { return 256u * row + 16u * (ch ^ (((row & 3u) << 2) | ((row >> 2) & 3u))); }
__device__ __forceinline__ void prep_phase(Frame& F, int l) {
    const int gw = F.vcu * NWAVES + F.wave, NGW = F.G * NWAVES, lane = F.lane;
    unsigned char* act = F.ws + WS_ACT;
    {
        const float* LFT = (const float*)(F.ws + WS_LF); float* Fo = (float*)(F.ws + WS_F);
        for (int task = gw; task < BATCH * 16 * 16; task += NGW) {
            const int bh = task >> 4, seg = task & 15; const float* src = LFT + (size_t)bh * SEQ + 4 * lane;
            const f32x4 own = *(const f32x4*)(src + seg * 256);
            f32x4 prv[15];
#pragma unroll
            for (int q = 0; q < 15; ++q) prv[q] = *(const f32x4*)(src + (q < seg ? q : 0) * 256);
            float part = 0.f;
#pragma unroll
            for (int q = 0; q < 15; ++q) part += (q < seg) ? ((prv[q][0] + prv[q][1]) + (prv[q][2] + prv[q][3])) : 0.f;
            const float off = wave_sum(part, lane);
            const float c0 = own[0], c1 = c0 + own[1], c2 = c1 + own[2], c3 = c2 + own[3];
            float pre = c3;
#pragma unroll
            for (int o = 1; o < 64; o <<= 1) { const float t = shfl_idx(pre, lane - o); if (lane >= o) pre += t; }
            const float base = off + (pre - c3);
            const f32x4 fv = (f32x4){(base + c0) * LOG2E, (base + c1) * LOG2E, (base + c2) * LOG2E, (base + c3) * LOG2E};
            *(f32x4*)(Fo + (size_t)bh * SEQ + seg * 256 + 4 * lane) = fv;
            v4u* kx = (v4u*)(F.ws + WS_KX) + (size_t)bh * SEQ + seg * 256 + 4 * lane;
#pragma unroll
            for (int i = 0; i < 4; ++i) { const float nf = -fv[i];
                const unsigned h0 = f2bf(nf); const float r1 = nf - __uint_as_float(h0 << 16); const unsigned h1 = f2bf(r1); const float r2 = r1 - __uint_as_float(h1 << 16); const unsigned h2 = f2bf(r2);
                kx[i] = (v4u){h0 | (h1 << 16), h2 | 0xBF800000u, 0xBF80BF80u, 0u}; }
        }
    }
    {
        LAS unsigned char* sb = F.lds + RING_OFF + F.wave * 16384;
        LAS unsigned short* Zs = (LAS unsigned short*)sb; LAS unsigned short* Qs = (LAS unsigned short*)(sb + 4608);
        const unsigned char* HQ = act + 3 * ACTB; const unsigned char* HF = act + 4 * ACTB;
        LAS unsigned char* Z8 = sb + 9216; LAS unsigned char* Q8 = sb + 9216 + 2560;
        float* DL = (float*)(F.ws + WS_DL);
        const float* lbp = (const float*)(F.ws + WS_LB) + l * 1024;
        const int r = lane >> 1, c0 = (lane & 1) * 32;
        v4u nz[2], nq[2];
        if (gw < 1024 * 16) { const size_t ro0 = ((size_t)(gw >> 4) * 32 + r) * D + 64 * (gw & 15) + c0; const v4u* pz = (const v4u*)(HF + ro0); const v4u* pq = (const v4u*)(HQ + ro0);
#pragma unroll
            for (int k = 0; k < 2; ++k) { nz[k] = pz[k]; nq[k] = pq[k]; } }
        for (int it = gw; it < 1024 * 16; it += NGW) {
            const int ck = it >> 4, cg = it & 15;
            {
#pragma unroll
                for (int k = 0; k < 2; ++k) { *(LAS v4u*)(Z8 + r * 80 + c0 + 16 * k) = nz[k]; *(LAS v4u*)(Q8 + r * 80 + c0 + 16 * k) = nq[k]; }
                const int itn = it + NGW;
                if (itn < 1024 * 16) { const size_t ron = ((size_t)(itn >> 4) * 32 + r) * D + 64 * (itn & 15) + c0; const v4u* pz = (const v4u*)(HF + ron); const v4u* pq = (const v4u*)(HQ + ron);
#pragma unroll
                    for (int k = 0; k < 2; ++k) { nz[k] = pz[k]; nq[k] = pq[k]; } }
            }
            LDS_WAIT(); __builtin_amdgcn_wave_barrier(); asm volatile("" ::: "memory");
            {
                const int ch = 64 * cg + lane; const float lb = lbp[ch], oml = 1.0f - lb;
                float E = 1.0f;
#pragma unroll
                for (int t = 0; t < 32; ++t) {
                    const float z = __builtin_amdgcn_cvt_f32_fp8((int)Z8[t * 80 + lane], 0), qr_ = __builtin_amdgcn_cvt_f32_fp8((int)Q8[t * 80 + lane], 0), q = qr_ * pg8::sigmoid_f(qr_);
                    const float e = __builtin_amdgcn_exp2f(-LOG2E * z), inv = __builtin_amdgcn_rcpf(1.0f + e);
                    const float f = fmaxf(lb + oml * inv, 1e-20f), kk = oml * (e * inv);
                    E *= f;
                    const float qt = q * E, ktv = kk * fminf(__builtin_amdgcn_rcpf(E), 5.540622e34f);
                    Qs[t * 72 + lane] = (unsigned short)f2bf(qt); Zs[t * 72 + lane] = (unsigned short)f2bf(ktv);
                }
                DL[(size_t)ck * 1024 + ch] = E;
            }
            LDS_WAIT(); __builtin_amdgcn_wave_barrier(); asm volatile("" ::: "memory");
            {
                unsigned char* tq = F.ws + WS_QF + (size_t)(ck * 8 + (cg >> 1)) * 8192; unsigned char* tk = F.ws + WS_KF + (size_t)(ck * 8 + (cg >> 1)) * 8192;
#pragma unroll
                for (int k = 0; k < 4; ++k) { const int chunk = 8 * (cg & 1) + 4 * (lane & 1) + k; const unsigned o = hg_offb((unsigned)r, (unsigned)chunk);
                    *(v4u*)(tq + o) = *(const LAS v4u*)(Qs + r * 72 + c0 + 8 * k); *(v4u*)(tk + o) = *(const LAS v4u*)(Zs + r * 72 + c0 + 8 * k); }
            }
            LDS_WAIT(); __builtin_amdgcn_wave_barrier(); asm volatile("" ::: "memory");
        }
    }
}

typedef float f32x16 __attribute__((ext_vector_type(16)));
#define MFMA32(a, b, c) __builtin_amdgcn_mfma_f32_32x32x16_bf16(a, b, c, 0, 0, 0)
__device__ __forceinline__ bf16x8 pack8(const f32x16& x, int s) {
    v4u w; w.x = pk2(x[8 * s], x[8 * s + 1]); w.y = pk2(x[8 * s + 2], x[8 * s + 3]); w.z = pk2(x[8 * s + 4], x[8 * s + 5]); w.w = pk2(x[8 * s + 6], x[8 * s + 7]);
    return __builtin_bit_cast(bf16x8, w);
}
constexpr int HG_NSC = 8, HG_CPS = 16, HG_UNITS = 64 * HG_NSC;
template <bool OUT> __device__ __forceinline__ void hg_pipe(Frame& F, int l) {
    const int lane = F.lane, r32 = lane & 31, hi = lane >> 5;
    const int grp = F.wave >> 2, vb = F.wave & 3;
    unsigned char* act = F.ws + WS_ACT;
    const unsigned char* QTg = F.ws + WS_QF; const unsigned char* KTg = F.ws + WS_KF; const unsigned char* HIg = act + 5 * ACTB;
    bf16* OH = (bf16*)(act + 5 * ACTB); const float* DL = (const float*)(F.ws + WS_DL);
    float* U = (float*)(F.ws + WS_U); float* DSC = (float*)(F.ws + WS_DSC);
    const unsigned ldsg = (unsigned)(uintptr_t)(F.lds + RING_OFF) + (unsigned)grp * 65536u;
    const LAS unsigned char* lg = F.lds + RING_OFF + grp * 65536;
    const unsigned voff = (unsigned)lane * 16u;
    typedef short v4i16_t __attribute__((ext_vector_type(4)));
    const int rpi = (r32 & ~12) | ((r32 & 4) << 1) | ((r32 & 8) >> 1);
    const int xq = ((r32 & 3) << 2) | ((r32 >> 2) & 3), xk = ((rpi & 3) << 2) | ((rpi >> 2) & 3);
    const int trr0 = 8 * hi + ((lane & 15) >> 2), trcb = 2 * ((lane >> 4) & 1) + ((lane & 3) >> 1), trp8 = 8 * (lane & 1);
    const int trx0 = ((trr0 & 3) << 2) | ((2 * hi) & 3);
    LAS unsigned char* tile = F.lds + HGT_OFF + grp * HGT_BYTES;
    const int mtok = 8 * vb + (lane >> 3), mcol = (lane & 7) * 16;
    const float* ogp = gptr(F, IN_OG) + l * 128 + mcol;
    v4u mi[2], mh[2], mg[2];
#define HG_MLOAD(tokc_) do { const size_t ro_ = ((size_t)((tokc_) + mtok) * D + 128 * h + mcol) * 2; \
        mi[0] = *(const v4u*)(act + 0 * ACTB + ro_); mi[1] = *(const v4u*)(act + 0 * ACTB + ro_ + 16); mh[0] = *(const v4u*)(act + 6 * ACTB + ro_); mh[1] = *(const v4u*)(act + 6 * ACTB + ro_ + 16); \
        _Pragma("unroll") for (int g_ = 0; g_ < 2; ++g_) mg[g_] = *(const v4u*)(act + (size_t)(7 + g_) * ACTB + (ro_ >> 1)); } while (0)
#define HG_MERGE(tokc_) do { float oh_[16]; \
        _Pragma("unroll") for (int q_ = 0; q_ < 2; ++q_) { const v4u w_ = *(const LAS v4u*)(tile + mtok * HGT_PITCH + mcol * 2 + 16 * q_); \
            oh_[8 * q_] = bflo(w_.x); oh_[8 * q_ + 1] = bfhi(w_.x); oh_[8 * q_ + 2] = bflo(w_.y); oh_[8 * q_ + 3] = bfhi(w_.y); oh_[8 * q_ + 4] = bflo(w_.z); oh_[8 * q_ + 5] = bfhi(w_.z); oh_[8 * q_ + 6] = bflo(w_.w); oh_[8 * q_ + 7] = bfhi(w_.w); } \
        float ss_ = 0.f; _Pragma("unroll") for (int i_ = 0; i_ < 16; ++i_) ss_ += oh_[i_] * oh_[i_]; \
        ss_ += shfl_idx(ss_, lane ^ 1); ss_ += shfl_idx(ss_, lane ^ 2); ss_ += shfl_idx(ss_, lane ^ 4); \
        const float rstd_ = 1.0f / sqrtf(ss_ * (1.0f / 128.0f) + EPS); \
        const size_t ro_ = ((size_t)((tokc_) + mtok) * D + 128 * h + mcol) * 2; \
        _Pragma("unroll") for (int q_ = 0; q_ < 2; ++q_) { const f32x4 g0_ = *(const f32x4*)(ogp + 8 * q_), g1_ = *(const f32x4*)(ogp + 8 * q_ + 4); const float og_[8] = {g0_[0], g0_[1], g0_[2], g0_[3], g1_[0], g1_[1], g1_[2], g1_[3]}; \
            const unsigned aw_[4] = {mi[q_].x, mi[q_].y, mi[q_].z, mi[q_].w}, gw_[4] = {mh[q_].x, mh[q_].y, mh[q_].z, mh[q_].w}; \
            const unsigned ga_[2] = {q_ ? mg[0].z : mg[0].x, q_ ? mg[0].w : mg[0].y}, gb_[2] = {q_ ? mg[1].z : mg[1].x, q_ ? mg[1].w : mg[1].y}; \
            float y_[8]; _Pragma("unroll") for (int p_ = 0; p_ < 4; ++p_) { const float h0_ = bflo(gw_[p_]), h1_ = bfhi(gw_[p_]); \
                const float a0_ = (p_ & 1) ? __builtin_amdgcn_cvt_f32_fp8((int)ga_[p_ >> 1], 2) : __builtin_amdgcn_cvt_f32_fp8((int)ga_[p_ >> 1], 0), a1_ = (p_ & 1) ? __builtin_amdgcn_cvt_f32_fp8((int)ga_[p_ >> 1], 3) : __builtin_amdgcn_cvt_f32_fp8((int)ga_[p_ >> 1], 1); \
                const float b0_ = (p_ & 1) ? __builtin_amdgcn_cvt_f32_fp8((int)gb_[p_ >> 1], 2) : __builtin_amdgcn_cvt_f32_fp8((int)gb_[p_ >> 1], 0), b1_ = (p_ & 1) ? __builtin_amdgcn_cvt_f32_fp8((int)gb_[p_ >> 1], 3) : __builtin_amdgcn_cvt_f32_fp8((int)gb_[p_ >> 1], 1); \
                y_[2 * p_] = pg8::sigmoid_f(a0_) * bflo(aw_[p_]) + pg8::sigmoid_f(b0_) * (oh_[8 * q_ + 2 * p_] * rstd_ * og_[2 * p_] * (h0_ * pg8::sigmoid_f(h0_))); \
                y_[2 * p_ + 1] = pg8::sigmoid_f(a1_) * bfhi(aw_[p_]) + pg8::sigmoid_f(b1_) * (oh_[8 * q_ + 2 * p_ + 1] * rstd_ * og_[2 * p_ + 1] * (h1_ * pg8::sigmoid_f(h1_))); } \
            *(v4u*)(F.ws + WS_XN + ro_ + 16 * q_) = (v4u){pk2(y_[0], y_[1]), pk2(y_[2], y_[3]), pk2(y_[4], y_[5]), pk2(y_[6], y_[7])}; } } while (0)
    const int ntrip = (HG_UNITS + 2 * F.G - 1) / (2 * F.G);
    for (int trip = 0; trip < ntrip; ++trip) {
        const int unit = (trip * F.G + F.vcu) * 2 + grp; const bool live = unit < HG_UNITS;
        const int bh = unit >> 3, sc = unit & 7, b = bh >> 3, h = bh & 7;
        const int tok0 = b * SEQ + sc * (32 * HG_CPS), ck0 = tok0 >> 5;
#define HG_DMA(j, bi) do { if (live) { const size_t go_ = ((size_t)(ck0 + (j)) * 8 + h) * 8192; const unsigned lb_ = ldsg + (unsigned)(bi) * 32768u; \
            const unsigned char* vs_ = HIg + ((size_t)(tok0 + 32 * (j)) * D + 128 * h) * 2; \
            _Pragma("unroll") for (int pp_ = 0; pp_ < 2; ++pp_) { const int pc_ = vb + 4 * pp_; \
                if (OUT) attn_body::glds16s(voff, QTg + go_ + pc_ * 1024, (unsigned)__builtin_amdgcn_readfirstlane(lb_ + pc_ * 1024)); \
                attn_body::glds16s(voff, KTg + go_ + pc_ * 1024, (unsigned)__builtin_amdgcn_readfirstlane(lb_ + 8192 + pc_ * 1024)); \
                  \
                { const unsigned vo_ = (unsigned)((4 * pc_ + (lane >> 4)) * 2048 + 16 * ((lane & 15) ^ (((lane >> 4) << 2) | (pc_ & 3)))); \
                  attn_body::glds16s(vo_, vs_, (unsigned)__builtin_amdgcn_readfirstlane(lb_ + 16384 + pc_ * 1024)); } } \
              \
            if (vb == 0) attn_body::glds16s(voff, (const unsigned char*)(DL + (size_t)(ck0 + (j)) * 1024 + 128 * h), (unsigned)__builtin_amdgcn_readfirstlane(lb_ + 24576)); } } while (0)
#define HG_ROWF(bi, toff, row, x, ch) (*(const LAS bf16x8*)(lg + (bi) * 32768 + (toff) + 256 * (row) + 16 * ((ch) ^ (x))))
#define HG_TRF(dst, bi, toff, c, ks) do { v4i16_t lo_, hi_; \
            { const int ch0_ = (4 * (c) + trcb) ^ trx0, ch1_ = (4 * (c) + trcb) ^ (trx0 | 1); \
              lo_ = __builtin_amdgcn_ds_read_tr16_b64_v4i16((LAS v4i16_t*)(lg + (bi) * 32768 + (toff) + 256 * (16 * (ks) + trr0) + 16 * ch0_ + trp8)); \
              hi_ = __builtin_amdgcn_ds_read_tr16_b64_v4i16((LAS v4i16_t*)(lg + (bi) * 32768 + (toff) + 256 * (16 * (ks) + trr0 + 4) + 16 * ch1_ + trp8)); } \
            dst = (bf16x8){lo_[0], lo_[1], lo_[2], lo_[3], hi_[0], hi_[1], hi_[2], hi_[3]}; } while (0)
        HG_DMA(0, 0);
        f32x16 S[4];
#pragma unroll
        for (int kb = 0; kb < 4; ++kb) S[kb] = f32x16{};
        if (OUT && live) {
            for (int j = 0; j < sc; ++j) { const int uj = bh * HG_NSC + j;
#pragma unroll
                for (int kb = 0; kb < 4; ++kb) { const float* dp = DSC + (size_t)uj * 128 + 32 * kb + 4 * hi; const f32x4 d0 = *(const f32x4*)dp, d1 = *(const f32x4*)(dp + 8), d2 = *(const f32x4*)(dp + 16), d3 = *(const f32x4*)(dp + 24);
                    const float dd[16] = {d0[0], d0[1], d0[2], d0[3], d1[0], d1[1], d1[2], d1[3], d2[0], d2[1], d2[2], d2[3], d3[0], d3[1], d3[2], d3[3]};
                    const unsigned* up = (const unsigned*)U + (((size_t)uj * 4 + vb) * 32 + kb * 8) * 64 + lane;
                    unsigned uw[8];
#pragma unroll
                    for (int rp = 0; rp < 8; ++rp) uw[rp] = up[(size_t)rp * 64];
#pragma unroll
                    for (int rp = 0; rp < 8; ++rp) { S[kb][2 * rp] = S[kb][2 * rp] * dd[2 * rp] + pg8::xlo(uw[rp]); S[kb][2 * rp + 1] = S[kb][2 * rp + 1] * dd[2 * rp + 1] + pg8::xhi(uw[rp]); } } }
        }
        asm volatile("s_waitcnt vmcnt(0) lgkmcnt(0)\n\ts_barrier" ::: "memory");
        for (int j = 0; j < HG_CPS; ++j) {
            const int bi = j & 1, ck = ck0 + j, tokc = tok0 + 32 * j;
            if (OUT && live && j > 0) HG_MERGE(tokc - 32);
            if (j + 1 < HG_CPS) HG_DMA(j + 1, bi ^ 1);
            if (OUT) { asm volatile("s_waitcnt lgkmcnt(0)\n\ts_barrier" ::: "memory");
                       if (live) HG_MLOAD(tokc); }
            if (live) {
                bf16x8 vt[2];
#pragma unroll
                for (int st = 0; st < 2; ++st) HG_TRF(vt[st], bi, 16384, vb, st);
                if (OUT) {
                    f32x16 X = f32x16{};
#pragma unroll
                    for (int ks = 0; ks < 8; ++ks) X = MFMA32(HG_ROWF(bi, 8192, rpi, xk, 2 * ks + hi), HG_ROWF(bi, 0, r32, xq, 2 * ks + hi), X);
#pragma unroll
                    for (int r = 0; r < 16; ++r) { const int s_ = 16 * (r >> 3) + 8 * hi + (r & 7); X[r] = (s_ > r32) ? 0.f : X[r]; }
                    const bf16x8 P0 = pack8(X, 0), P1 = pack8(X, 1);
                    f32x16 o = f32x16{};
                    o = MFMA32(P0, vt[0], o); o = MFMA32(P1, vt[1], o);
#pragma unroll
                    for (int kb = 0; kb < 4; ++kb)
#pragma unroll
                        for (int hf_ = 0; hf_ < 2; ++hf_) { const int s_ = 2 * kb + hf_;
                            const pg8::u32x2 qa_ = *(const LAS pg8::u32x2*)(lg + bi * 32768 + 256 * r32 + 16 * ((2 * s_) ^ xq) + 8 * hi), qb_ = *(const LAS pg8::u32x2*)(lg + bi * 32768 + 256 * r32 + 16 * ((2 * s_ + 1) ^ xq) + 8 * hi);
                            o = MFMA32(__builtin_bit_cast(bf16x8, (v4u){qa_.x, qa_.y, qb_.x, qb_.y}), pack8(S[kb], hf_), o); }
#pragma unroll
                    for (int r = 0; r < 16; ++r) { const int t = 8 * (r >> 2) + 4 * hi + (r & 3); *(LAS unsigned short*)(tile + t * HGT_PITCH + (32 * vb + r32) * 2) = (unsigned short)f2bf(o[r]); }
                }
#pragma unroll
                for (int kb = 0; kb < 4; ++kb) {
#pragma unroll
                    for (int st = 0; st < 2; ++st) { bf16x8 kf_; HG_TRF(kf_, bi, 8192, kb, st); S[kb] = MFMA32(kf_, vt[st], S[kb]); }
                    const LAS float* dp = (const LAS float*)(lg + bi * 32768 + 24576) + 32 * kb + 4 * hi; const f32x4 d0 = *(const LAS f32x4*)dp, d1 = *(const LAS f32x4*)(dp + 8), d2 = *(const LAS f32x4*)(dp + 16), d3 = *(const LAS f32x4*)(dp + 24);
                    const float dd[16] = {d0[0], d0[1], d0[2], d0[3], d1[0], d1[1], d1[2], d1[3], d2[0], d2[1], d2[2], d2[3], d3[0], d3[1], d3[2], d3[3]};
#pragma unroll
                    for (int r = 0; r < 16; ++r) S[kb][r] *= dd[r];
                }
            }
            asm volatile("s_waitcnt vmcnt(0) lgkmcnt(0)\n\ts_barrier" ::: "memory");
        }
        if (OUT && live) HG_MERGE(tok0 + 32 * (HG_CPS - 1));
        if (OUT) asm volatile("s_waitcnt lgkmcnt(0)\n\ts_barrier" ::: "memory");
        if (!OUT && live) {
#pragma unroll
            for (int kb = 0; kb < 4; ++kb) { unsigned* up = (unsigned*)U + (((size_t)unit * 4 + vb) * 32 + kb * 8) * 64 + lane;
#pragma unroll
                for (int rp = 0; rp < 8; ++rp) up[(size_t)rp * 64] = pg8::xpk(S[kb][2 * rp], S[kb][2 * rp + 1]); }
            if (vb == 0) {
#pragma unroll
                for (int half = 0; half < 2; ++half) { const int ch = lane + 64 * half; float p = 1.0f;
                    for (int j = 0; j < HG_CPS; ++j) p *= DL[(size_t)(ck0 + j) * 1024 + 128 * h + ch];
                    DSC[(size_t)unit * 128 + ch] = p; }
            }
        }
#undef HG_DMA
#undef HG_ROWF
#undef HG_TRF
    }
    asm volatile("s_waitcnt vmcnt(0) lgkmcnt(0)" ::: "memory");
#undef HG_MLOAD
#undef HG_MERGE
}
template <bool OUT> __device__ __forceinline__ void hg_phase(Frame& F, int l) { hg_pipe<OUT>(F, l); }

__device__ __forceinline__ void merge_phase(Frame& F, int l) {
    const int gw = F.vcu * NWAVES + F.wave, NGW = F.G * NWAVES, lane = F.lane;
    unsigned char* act = F.ws + WS_ACT;
    float og[16];
#pragma unroll
    for (int i = 0; i < 16; ++i) og[i] = gptr(F, IN_OG)[l * 128 + (lane & 7) * 16 + i];
    for (int row = gw; row < NTOK; row += NGW) {
        const size_t ro = (size_t)row * 2048 + 32 * lane;
        const v4u* pa = (const v4u*)(act + 0 * ACTB + ro); const v4u* ph = (const v4u*)(act + 5 * ACTB + ro); const v4u* pg = (const v4u*)(act + 6 * ACTB + ro);
        const v4u* pga = (const v4u*)(act + 7 * ACTB + ro); const v4u* pgb = (const v4u*)(act + 8 * ACTB + ro);
        v4u out[2]; float oh[16];
#pragma unroll
        for (int k = 0; k < 2; ++k) { const v4u w = ph[k]; oh[8 * k] = bflo(w.x); oh[8 * k + 1] = bfhi(w.x); oh[8 * k + 2] = bflo(w.y); oh[8 * k + 3] = bfhi(w.y); oh[8 * k + 4] = bflo(w.z); oh[8 * k + 5] = bfhi(w.z); oh[8 * k + 6] = bflo(w.w); oh[8 * k + 7] = bfhi(w.w); }
        float ss = 0.f;
#pragma unroll
        for (int i = 0; i < 16; ++i) ss += oh[i] * oh[i];
        ss += shfl_idx(ss, lane ^ 1); ss += shfl_idx(ss, lane ^ 2); ss += shfl_idx(ss, lane ^ 4);
        const float rstd = 1.0f / sqrtf(ss * (1.0f / 128.0f) + EPS);
#pragma unroll
        for (int k = 0; k < 2; ++k) { const v4u wa = pa[k], wg = pg[k], wga = pga[k], wgb = pgb[k]; float y[8];
            const unsigned aw[4] = {wa.x, wa.y, wa.z, wa.w}, gw_[4] = {wg.x, wg.y, wg.z, wg.w}, gaw[4] = {wga.x, wga.y, wga.z, wga.w}, gbw[4] = {wgb.x, wgb.y, wgb.z, wgb.w};
#pragma unroll
            for (int q = 0; q < 4; ++q) {
                const float g0 = bflo(gw_[q]), g1 = bfhi(gw_[q]);
                y[2 * q] = pg8::sigmoid_f(bflo(gaw[q])) * bflo(aw[q]) + pg8::sigmoid_f(bflo(gbw[q])) * (oh[8 * k + 2 * q] * rstd * og[8 * k + 2 * q] * (g0 * pg8::sigmoid_f(g0)));
                y[2 * q + 1] = pg8::sigmoid_f(bfhi(gaw[q])) * bfhi(aw[q]) + pg8::sigmoid_f(bfhi(gbw[q])) * (oh[8 * k + 2 * q + 1] * rstd * og[8 * k + 2 * q + 1] * (g1 * pg8::sigmoid_f(g1))); }
            out[k] = (v4u){pk2(y[0], y[1]), pk2(y[2], y[3]), pk2(y[4], y[5]), pk2(y[6], y[7])}; }
        v4u* po = (v4u*)(F.ws + WS_XN + ro); po[0] = out[0]; po[1] = out[1];
    }
}

struct Args { const float* in[21]; float* out; unsigned char* ws; int ph_lo, ph_hi; };
__global__ void __launch_bounds__(NWAVES * 64, 2) trunk_fwd(Args args) {
    extern __shared__ __attribute__((aligned(16))) unsigned char lds[];
    Frame F;
    F.lds = (LAS unsigned char*)lds;
    F.MISC = (volatile LAS unsigned*)(F.lds + MISC_OFF);
    F.tid = threadIdx.x; F.lane = F.tid & 63; F.wave = __builtin_amdgcn_readfirstlane(F.tid >> 6);
    F.G = gridDim.x; { const int bx = blockIdx.x; F.vcu = (F.G % 8 == 0) ? (bx % 8) * (F.G / 8) + bx / 8 : bx; }
    F.ws = args.ws; F.ctl = (gu32*)(args.ws + WS_CTL);
    for (int u = F.tid; u < (LDS_BYTES - LDSCTL_OFF) / 4; u += NWAVES * 64) ((LAS unsigned*)(F.lds + LDSCTL_OFF))[u] = 0u;
    __syncthreads();
    if (F.tid < 22) { const unsigned long long p = (F.tid < 21) ? (unsigned long long)args.in[F.tid] : (unsigned long long)args.out;
        LAS unsigned* t = (LAS unsigned*)(F.lds + PTAB_OFF) + 2 * F.tid; t[0] = (unsigned)p; t[1] = (unsigned)(p >> 32); }
    __syncthreads();
    XcdBarrier bar = xcd_barrier_post((unsigned*)(F.ctl + CW_BAR), F.MISC + 8);
#define GRID_BAR() do { XcdBarrier b_ = bar; { GAS unsigned* g_ = (GAS unsigned*)b_.bar; asm volatile("" : "+s"(g_)); b_.bar = (unsigned*)g_; } xcd_barrier(b_); } while (0)
    const int lo = args.ph_lo, hi = args.ph_hi; int ph = 0;
#define PHASE_BEGIN if (ph >= lo && ph < hi) { Frame P = F; asm volatile("" : "+v"(P.tid)); asm volatile("" : "+s"(P.vcu), "+s"(P.G)); { GAS unsigned char* g_ = (GAS unsigned char*)P.ws; asm volatile("" : "+s"(g_)); P.ws = (unsigned char*)g_; } P.lane = P.tid & 63; P.wave = __builtin_amdgcn_readfirstlane(P.tid >> 6); P.ctl = (gu32*)P.ws;
#define PHASE_END   if (ph + 1 < hi) GRID_BAR(); } ++ph;
#ifndef REP_MASK
#define REP_MASK 0
#endif
#define REPEAT(bit) for (int rep_ = 0; rep_ < ((REP_MASK & (bit)) ? 2 : 1); ++rep_)

    PHASE_BEGIN REPEAT(4) { p0_prologue(P); __syncthreads(); } PHASE_END
    PHASE_BEGIN ada_final(P); PHASE_END

    for (int l = 0; l < DEPTH; ++l) {
        const bool moe = (l & 1); const int fi = l >> 1;
        PHASE_BEGIN if ((l > 0) && ((l - 1) & 1)) row_phase<false, true>(P, false, l - 1, 1, l); else row_phase<false, false>(P, l == 0, 0, 1, l); PHASE_END
        PHASE_BEGIN {
            { pg8::Gemm g{(const bf16*)(P.ws + WS_XN8), (const bf16*)(P.ws + WS_WIN + (size_t)l * D_INP * D), NTOK, D_INP, D / 2}; pg8::TileOrder S; S.init(NTOK / 256, D_INP / 256, P.G, (int)blockIdx.x); S.tmode = 2;
              float sc_ = 1.0f / 32.0f; asm volatile("" : "+s"(sc_));
              pg8::EpiInProj E{(bf16*)(P.ws + WS_ACT), ACTB / 2, (float*)(P.ws + WS_LF), gptr(P, IN_FB) + l * 16, gptr(P, IN_QG) + l * 64, gptr(P, IN_KG) + l * 64, sc_};
              REPEAT(1) { int tid_ = P.tid; asm volatile("" : "+v"(tid_)); pg8::gemm_phase<pg8::EpiInProj, pg8::TileOrder, PG8_ALIGN, PG8_SP2, true>(P.lds + RING_OFF, g, S, E, tid_); } }
        } PHASE_END
        PHASE_BEGIN prep_phase(P, l); PHASE_END
        PHASE_BEGIN {
            if ((((int)blockIdx.x >> 3) & 1) == 0) { REPEAT(16) hg_phase<false>(P, l); asm volatile("s_waitcnt vmcnt(0) lgkmcnt(0)" ::: "memory"); __syncthreads(); }
            {
                unsigned char* act = P.ws + WS_ACT;
                REPEAT(2) {
                const attn_body::AttnTensors AT{(const attn_body::bf16*)(act + 0 * ACTB), (const attn_body::bf16*)(act + 1 * ACTB), (const attn_body::bf16*)(act + 2 * ACTB), (attn_body::bf16*)(((REP_MASK & 2) && rep_ == 0) ? P.ws + WS_XN : act + 0 * ACTB), (const float*)(P.ws + WS_F), (const attn_body::bf16*)(P.ws + WS_KX)};
                const attn_body::StaticOrder S((int)P.G, P.vcu);
                attn_body::attn_phase<attn_body::StaticOrder>((char*)lds + RING_OFF, AT, S, P.tid);
                }
            }
            if ((((int)blockIdx.x >> 3) & 1) != 0) { asm volatile("s_waitcnt vmcnt(0) lgkmcnt(0)" ::: "memory"); __syncthreads();
                Frame P2 = F; asm volatile("" : "+v"(P2.tid)); asm volatile("" : "+s"(P2.vcu), "+s"(P2.G)); { GAS unsigned char* g_ = (GAS unsigned char*)P2.ws; asm volatile("" : "+s"(g_)); P2.ws = (unsigned char*)g_; }
                P2.lane = P2.tid & 63; P2.wave = __builtin_amdgcn_readfirstlane(P2.tid >> 6); P2.ctl = (gu32*)P2.ws;
                REPEAT(16) hg_phase<false>(P2, l); }
        } PHASE_END
        PHASE_BEGIN REPEAT(32) hg_phase<true>(P, l); PHASE_END
        PHASE_BEGIN {
            pg8::Gemm g{(const bf16*)(P.ws + WS_XN), (const bf16*)(P.ws + WS_WOUT) + (size_t)l * D * D, NTOK, D, D}; pg8::TileOrder S; S.init(NTOK / 256, D / 256, P.G, (int)blockIdx.x);
            bf16* const xb = (bf16*)(P.ws + WS_XB);
            pg8::EpiResid E{xb, xb, (const float*)(P.ws + WS_ADA) + (size_t)l * 8 * ADAW + 2 * D, ADAW, nullptr, 0, 1.0f};
            pg8::gemm_phase<pg8::EpiResid, pg8::TileOrder, PG8_ALIGN, PG8_SP2>(P.lds + RING_OFF, g, S, E, P.tid);
        } PHASE_END
        PHASE_BEGIN if (moe) row_phase<true, false>(P, false, 0, 2, l); else row_phase<false, false>(P, false, 0, 2, l); if (moe) { __syncthreads(); REPEAT(4) moe_weights(P, fi); } PHASE_END
        if (moe) { PHASE_BEGIN moe_scatter(P, fi); PHASE_END }
        PHASE_BEGIN {
            pg8::TileOrder S;
            if (moe) { int off[9], ncnt[8]; moe_offsets(P.ctl + CW_CNT + fi * 8 * 64, off, ncnt); S.init(off[8] >> 8, 2 * DFE / 256, P.G, (int)blockIdx.x); S.nbt = 2 * DFE / 256;
#pragma unroll
                for (int e = 0; e < 8; ++e) S.cum[e] = off[e] >> 8;
                const pg8::Gemm g{(const bf16*)(P.ws + WS_HS), (const bf16*)(P.ws + WS_WMGU), off[8], 2 * DFE, D / 2};
                float sc_ = 1.0f / MOE_WS_GU; asm volatile("" : "+s"(sc_));
                const pg8::EpiSwiGLU8 E{P.ws + WS_INTER_M, DFE, sc_};
                REPEAT(8) { int tid_ = P.tid; asm volatile("" : "+v"(tid_)); pg8::gemm_phase<pg8::EpiSwiGLU8, pg8::TileOrder, PG8_ALIGN, PG8_SP2, true>(P.lds + RING_OFF, g, S, E, tid_); }
            } else {
                S.init(NTOK / 256, 2 * DFF / 256, P.G, (int)blockIdx.x);
                const pg8::Gemm g{(const bf16*)(P.ws + WS_XN), (const bf16*)(P.ws + WS_WGU) + (size_t)fi * 2 * DFF * D, NTOK, 2 * DFF, D};
                float one_ = 1.0f; asm volatile("" : "+s"(one_));
                const pg8::EpiSwiGLU8 E{P.ws + WS_INTER_D, DFF, one_};
                REPEAT(8) { int tid_ = P.tid; asm volatile("" : "+v"(tid_)); pg8::gemm_phase<pg8::EpiSwiGLU8, pg8::TileOrder, PG8_ALIGN, PG8_SP2>(P.lds + RING_OFF, g, S, E, tid_); }
            }
        } PHASE_END
        PHASE_BEGIN {
            pg8::TileOrder S;
            if (moe) { int off[9], ncnt[8]; moe_offsets(P.ctl + CW_CNT + fi * 8 * 64, off, ncnt); S.init(off[8] >> 8, D / 256, P.G, (int)blockIdx.x); S.nbt = D / 256;
#pragma unroll
                for (int e = 0; e < 8; ++e) S.cum[e] = off[e] >> 8;
                const pg8::Gemm g{(const bf16*)(P.ws + WS_INTER_M), (const bf16*)(P.ws + WS_WMDN), off[8], D, DFE / 2};
                float sc_ = 1.0f / MOE_WS_DN; asm volatile("" : "+s"(sc_));
                const pg8::EpiBf16S E{(bf16*)(P.ws + WS_HS), sc_};
                for (int rep_ = 0; rep_ < ((REP_MASK & 8) ? 2 : 1); ++rep_) { int tid_ = P.tid; asm volatile("" : "+v"(tid_)); pg8::gemm_phase<pg8::EpiBf16S, pg8::TileOrder, PG8_ALIGN, PG8_SP2, true>(P.lds + RING_OFF, g, S, E, tid_); }
            } else {
                S.init(NTOK / 256, D / 256, P.G, (int)blockIdx.x);
                bf16* const xb = (bf16*)(P.ws + WS_XB);
                const pg8::Gemm g{(const bf16*)(P.ws + WS_INTER_D), (const bf16*)(P.ws + WS_WDN + (size_t)fi * D * DFF), NTOK, D, DFF / 2};
                float sc_ = 1.0f / MOE_WS_DN; asm volatile("" : "+s"(sc_));
                const pg8::EpiResid E{xb, xb, (const float*)(P.ws + WS_ADA) + (size_t)l * 8 * ADAW + 5 * D, ADAW, nullptr, 0, sc_};
                { int tid_ = P.tid; asm volatile("" : "+v"(tid_)); pg8::gemm_phase<pg8::EpiResid, pg8::TileOrder, PG8_ALIGN, PG8_SP2, true>(P.lds + RING_OFF, g, S, E, tid_); }
            }
        } PHASE_END
    }
    PHASE_BEGIN row_phase<false, true>(P, false, 3, 0, 0); PHASE_END
#undef PHASE_BEGIN
#undef PHASE_END
}

#ifndef MK_SPLIT
#define MK_SPLIT 0
#endif
constexpr int N_PHASES = 2 + 4 * 9 + 2 * 1 + 1;
extern "C" void kernel_launch(void* const* d_in, const int* in_sizes, int n_in, void* d_out, int out_size, void* d_ws, size_t ws_size, hipStream_t stream) {
    static int grid = 0;
    if (grid == 0) {
        if (n_in != 21 || out_size != NTOK * D || ws_size < WS_END) { fprintf(stderr, "kernel_launch: unexpected sizes (n_in %d out %d ws %zu need %zu)\n", n_in, out_size, ws_size, (size_t)WS_END); grid = -1; return; }
        int dev = 0, cus = 0, per_cu = 0;
        if (hipGetDevice(&dev) != hipSuccess || hipDeviceGetAttribute(&cus, hipDeviceAttributeMultiprocessorCount, dev) != hipSuccess) { grid = -1; return; }
        if (hipFuncSetAttribute((const void*)trunk_fwd, hipFuncAttributeMaxDynamicSharedMemorySize, LDS_BYTES) != hipSuccess) { grid = -1; return; }
        if (hipOccupancyMaxActiveBlocksPerMultiprocessor(&per_cu, (const void*)trunk_fwd, NWAVES * 64, LDS_BYTES) != hipSuccess || per_cu < 1) fprintf(stderr, "kernel_launch: occupancy query says %d\n", per_cu);
        (void)hipGetLastError();
        grid = cus;
    }
    if (grid < 0) return;
    if (hipMemsetAsync((char*)d_ws + WS_CTL, 0, CTL_ZERO_BYTES, stream) != hipSuccess) return;
    Args a{};
    for (int i = 0; i < 21; ++i) a.in[i] = (const float*)d_in[i];
    a.out = (float*)d_out; a.ws = (unsigned char*)d_ws;
#if MK_SPLIT
    for (int p = 0; p < N_PHASES; ++p) { a.ph_lo = p; a.ph_hi = p + 1; hipLaunchKernelGGL(trunk_fwd, dim3(grid), dim3(NWAVES * 64), LDS_BYTES, stream, a); }
#else
    a.ph_lo = 0; a.ph_hi = N_PHASES;
    hipLaunchKernelGGL(trunk_fwd, dim3(grid), dim3(NWAVES * 64), LDS_BYTES, stream, a);
#endif
}
```

```cpp
#include <hip/hip_runtime.h>
#include <hip/hip_bf16.h>
#include <cstdio>
#include <cstdint>
#include <cmath>
namespace pg8 {
#define PG8_LAS __attribute__((address_space(3)))
typedef unsigned short bf16_t;
typedef short bf16x8 __attribute__((ext_vector_type(8)));
typedef float f32x4 __attribute__((ext_vector_type(4)));
typedef unsigned u32x4 __attribute__((ext_vector_type(4)));
constexpr int BM = 256, BK = 64, HALF = 128, HTB = HALF * BK * 2  , STAGE_BYTES = 8 * HTB, NXCD = 8, WGM = 8;

__host__ __device__ __forceinline__ int lds_byte(int r, int c) { const int st = (r >> 4) * 2 + (c >> 5), rr = r & 15, cc = c & 31, ob = rr * 64 + cc * 2; return st * 1024 + (ob ^ (((ob >> 9) & 1) << 5)); }
__host__ __device__ __forceinline__ void stage_rc(int b, int& R, int& C) { const int st = b / 1024, sb = b % 1024, swz = sb ^ (((sb >> 9) & 1) << 5); R = (st >> 1) * 16 + swz / 64; C = (st & 1) * 32 + (swz % 64) / 2; }
__host__ __device__ __forceinline__ int perm32(int rho) { const int n = rho >> 4, i = rho & 15; return 8 * (i >> 2) + 4 * n + (i & 3); }

struct Unit { int pm, pn, pb; };
struct Gemm { const bf16_t* A; const bf16_t* Bt; int M, N, K; };

struct TileOrder {
    int nM, nN, nwg, G, c, nbt; int cum[8]; int rm_from, rm_to, pn_off, bal, tmode;
    __device__ __forceinline__ void init(int nM_, int nN_, int G_, int c_) { nM = nM_; nN = nN_; nwg = nM * nN; G = G_; c = c_; nbt = 0; rm_from = -1; rm_to = 0; pn_off = 0; bal = 0; tmode = 0;
#pragma unroll
        for (int k = 0; k < 8; ++k) cum[k] = 0x7fffffff; }
    __device__ __forceinline__ bool next(int i, Unit& u) const {
        long L = (long)i * G + c;
        if (bal > 0 && i >= bal) { if (c < G / 2 || i >= bal + 2) return false; L = (long)bal * G + (long)(i - bal) * (G / 2) + (c - G / 2); }
        if (L >= nwg) return false;
        int wgid = (int)L; { const int q = nwg / NXCD, r = nwg % NXCD, xcd = wgid % NXCD, off = wgid / NXCD; wgid = (xcd < r ? xcd * (q + 1) : r * (q + 1) + (xcd - r) * q) + off; }
        const int nig = WGM * nN, gid = wgid / nig, fm = gid * WGM, gsz = (nM - fm) < WGM ? (nM - fm) : WGM;
        u.pm = fm + ((wgid % nig) % gsz); u.pn = (wgid % nig) / gsz;
        int e = 0;
#pragma unroll
        for (int k = 1; k < 8; ++k) e += (u.pm >= cum[k]) ? 1 : 0;
        int pnl = (u.pn == rm_from) ? rm_to : u.pn;
        if (tmode == 1) { pnl = pnl < 8 ? pnl : 36; u.pb = pnl; u.pn = pnl; return true; }
        if (tmode == 2) { u.pb = pnl; u.pn = pnl; return true; }
        u.pb = e * nbt + pnl; u.pn = pnl + pn_off; return true;
    }
    __device__ __forceinline__ void a_ready(const Unit&) const {}
    __device__ __forceinline__ void done(const Unit&) const {}
};

__device__ __forceinline__ unsigned cvt_pk_bf16(float lo, float hi) { unsigned r; asm volatile("v_cvt_pk_bf16_f32 %0, %1, %2" : "=v"(r) : "v"(lo), "v"(hi)); return r; }
__device__ __forceinline__ unsigned pk_fp8x4(float a, float b, float c, float d) { unsigned w = 0; w = __builtin_amdgcn_cvt_pk_fp8_f32(a, b, w, false); w = __builtin_amdgcn_cvt_pk_fp8_f32(c, d, w, true); return w; }
typedef unsigned u32x2 __attribute__((ext_vector_type(2)));
__device__ __forceinline__ float sigmoid_f(float v) { return __builtin_amdgcn_rcpf(1.0f + __builtin_amdgcn_exp2f(-1.4426950408889634f * v)); }
__device__ __forceinline__ f32x4 sigmoid4(f32x4 v) { return (f32x4){sigmoid_f(v[0]), sigmoid_f(v[1]), sigmoid_f(v[2]), sigmoid_f(v[3])}; }

struct EpiInProj {
    static constexpr bool PERM = true, AFTER_DRAIN = false;
    bf16_t* base; size_t bufstride; float* LF; const float* fbias; const float* qgain; const float* kgain; float s;
    __device__ __forceinline__ void operator()(const f32x4 (&acc)[2][2][4][2], const Unit& u, int wr, int wc, int fr, int fq) const {
        const int row0 = u.pm * BM + wr * 64 + fr;
        if (u.pn < 8) {
            const bool isq = u.pn < 4; const float* gp = (isq ? qgain : kgain) + 8 * fq; const float gs = isq ? 0.125f * 1.4426950408889634f : 1.0f;
            f32x4 gv[2][2];
#pragma unroll
            for (int bj = 0; bj < 2; ++bj)
#pragma unroll
                for (int n = 0; n < 2; ++n) gv[bj][n] = *(const f32x4*)(gp + 32 * bj + 4 * n) * gs;
            bf16_t* b = base + (size_t)(u.pn >> 2) * bufstride; const int col0 = 64 * (4 * (u.pn & 3) + wc) + 8 * fq;
#pragma unroll
            for (int ai = 0; ai < 2; ++ai)
#pragma unroll
                for (int m = 0; m < 4; ++m) { float ss = 0.f;
#pragma unroll
                    for (int bj = 0; bj < 2; ++bj)
#pragma unroll
                        for (int n = 0; n < 2; ++n) { const f32x4 x = acc[ai][bj][m][n]; ss += (x[0] * x[0] + x[1] * x[1]) + (x[2] * x[2] + x[3] * x[3]); }
                    { const unsigned su = __float_as_uint(ss); const auto r16 = __builtin_amdgcn_permlane16_swap(su, su, false, false); ss = __uint_as_float(r16[0]) + __uint_as_float(r16[1]); }
                    { const unsigned su = __float_as_uint(ss); const auto r32 = __builtin_amdgcn_permlane32_swap(su, su, false, false); ss = __uint_as_float(r32[0]) + __uint_as_float(r32[1]); }
                    const float rstd = s / sqrtf(ss * (s * s) * (1.0f / 64.0f) + 1e-6f);
                    bf16_t* rowp = b + (size_t)(row0 + ai * HALF + m * 16) * 1024 + col0;
#pragma unroll
                    for (int bj = 0; bj < 2; ++bj) { const f32x4 v0 = acc[ai][bj][m][0] * rstd * gv[bj][0], v1 = acc[ai][bj][m][1] * rstd * gv[bj][1];
                        u32x4 w; w.x = cvt_pk_bf16(v0[0], v0[1]); w.y = cvt_pk_bf16(v0[2], v0[3]); w.z = cvt_pk_bf16(v1[0], v1[1]); w.w = cvt_pk_bf16(v1[2], v1[3]);
                        __builtin_nontemporal_store(w, (u32x4*)(rowp + 32 * bj)); } }
        } else if ((u.pn >= 12 && u.pn < 20) || (u.pn >= 24 && u.pn < 28)) {
            unsigned char* b8 = (unsigned char*)(base + (size_t)(u.pn >> 2) * bufstride); const int colA = (u.pn & 3) * 256 + wc * 64 + 16 * fq;
#pragma unroll
            for (int ai = 0; ai < 2; ++ai)
#pragma unroll
                for (int m = 0; m < 4; ++m) { const f32x4 a0 = acc[ai][0][m][0] * s, a1 = acc[ai][0][m][1] * s, c0 = acc[ai][1][m][0] * s, c1 = acc[ai][1][m][1] * s;
                    u32x4 w; w.x = pk_fp8x4(a0[0], a0[1], a0[2], a0[3]); w.y = pk_fp8x4(a1[0], a1[1], a1[2], a1[3]); w.z = pk_fp8x4(c0[0], c0[1], c0[2], c0[3]); w.w = pk_fp8x4(c1[0], c1[1], c1[2], c1[3]);
                    __builtin_nontemporal_store(w, (u32x4*)(b8 + (size_t)(row0 + ai * HALF + m * 16) * 1024 + colA)); }
        } else if (u.pn >= 28 && u.pn < 36) {
            unsigned char* b8 = (unsigned char*)(base + (size_t)(u.pn >> 2) * bufstride); const int colA = (u.pn & 3) * 256 + wc * 64 + 16 * fq; const float sq_ = s * (255.0f / 16.0f);
#pragma unroll
            for (int ai = 0; ai < 2; ++ai)
#pragma unroll
                for (int m = 0; m < 4; ++m) { u32x4 w;
#pragma unroll
                    for (int q = 0; q < 4; ++q) { const f32x4 v = acc[ai][q >> 1][m][q & 1]; unsigned c[4];
#pragma unroll
                        for (int j = 0; j < 4; ++j) c[j] = __float_as_uint(__builtin_amdgcn_fmed3f(__builtin_fmaf(v[j], sq_, 127.5f), 0.f, 255.f) + 8388608.0f);
                        w[q] = __builtin_amdgcn_perm(c[1], c[0], 0x0c0c0400u) | __builtin_amdgcn_perm(c[3], c[2], 0x04000c0cu); }
                    __builtin_nontemporal_store(w, (u32x4*)(b8 + (size_t)(row0 + ai * HALF + m * 16) * 1024 + colA)); }
        } else if (u.pn < 36) {
            const int t = u.pn >> 2;
            bf16_t* b = base + (size_t)t * bufstride; const int col0 = (u.pn & 3) * 256 + wc * 32 + 8 * fq;
#pragma unroll
            for (int ai = 0; ai < 2; ++ai)
#pragma unroll
                for (int m = 0; m < 4; ++m) { bf16_t* rowp = b + (size_t)(row0 + ai * HALF + m * 16) * 1024 + col0;
#pragma unroll
                    for (int bj = 0; bj < 2; ++bj) { const f32x4 v0 = acc[ai][bj][m][0] * s, v1 = acc[ai][bj][m][1] * s;
                        u32x4 w; w.x = cvt_pk_bf16(v0[0], v0[1]); w.y = cvt_pk_bf16(v0[2], v0[3]); w.z = cvt_pk_bf16(v1[0], v1[1]); w.w = cvt_pk_bf16(v1[2], v1[3]);
                        __builtin_nontemporal_store(w, (u32x4*)(rowp + bj * HALF)); } }
        } else if (wc == 0 && fq < 2) {
#pragma unroll
            for (int n = 0; n < 2; ++n) { const f32x4 bv = *(const f32x4*)(fbias + 8 * fq + 4 * n);
#pragma unroll
                for (int ai = 0; ai < 2; ++ai)
#pragma unroll
                    for (int m = 0; m < 4; ++m) { const f32x4 x = acc[ai][0][m][n] * s + bv; f32x4 o;
#pragma unroll
                        for (int j = 0; j < 4; ++j) o[j] = fminf(x[j], 0.f) - 0.6931471805599453f * __builtin_amdgcn_logf(1.0f + __builtin_amdgcn_exp2f(-1.4426950408889634f * fabsf(x[j])));
                        { const int mrow = row0 + ai * HALF + m * 16; float* lp = LF + ((size_t)((mrow >> 12) * 16 + 8 * fq + 4 * n) << 12) + (mrow & 4095);
#pragma unroll
                          for (int j = 0; j < 4; ++j) lp[(size_t)j << 12] = o[j]; } } }
        }
    }
};

typedef float xf2_t __attribute__((ext_vector_type(2)));
typedef _Float16 xh2_t __attribute__((ext_vector_type(2)));
__device__ __forceinline__ unsigned xpk(float lo, float hi) { const xf2_t v = {lo, hi}; const xh2_t h = __builtin_convertvector(v, xh2_t); return __builtin_bit_cast(unsigned, h); }
__device__ __forceinline__ float xlo(unsigned w) { return (float)__builtin_bit_cast(xh2_t, w)[0]; }
__device__ __forceinline__ float xhi(unsigned w) { return (float)__builtin_bit_cast(xh2_t, w)[1]; }
struct EpiResid {
    static constexpr bool PERM = true, AFTER_DRAIN = false;
    const bf16_t* base; bf16_t* out; const float* gate; int gstride; bf16_t* O; int mode; float s;
    __device__ __forceinline__ void operator()(const f32x4 (&acc)[2][2][4][2], const Unit& u, int wr, int wc, int fr, int fq) const {
        const int row0 = u.pm * BM + wr * 64 + fr, col0 = u.pn * BM + wc * 32 + 8 * fq;
        if (mode == 0) {
            const float* g = gate + (size_t)((u.pm * BM) >> 12) * gstride + col0;
            f32x4 gv[2][2];
#pragma unroll
            for (int bj = 0; bj < 2; ++bj)
#pragma unroll
                for (int n = 0; n < 2; ++n) gv[bj][n] = *(const f32x4*)(g + bj * HALF + 4 * n) * s;
#pragma unroll
            for (int ai = 0; ai < 2; ++ai)
#pragma unroll
                for (int m = 0; m < 4; ++m) { const size_t off = (size_t)(row0 + ai * HALF + m * 16) * 1024 + col0;
#pragma unroll
                    for (int bj = 0; bj < 2; ++bj) { const u32x4 bs = *(const u32x4*)(base + off + bj * HALF);
                        f32x4 x0 = {xlo(bs.x), xhi(bs.x), xlo(bs.y), xhi(bs.y)};
                        f32x4 x1 = {xlo(bs.z), xhi(bs.z), xlo(bs.w), xhi(bs.w)};
                        x0 = x0 + gv[bj][0] * acc[ai][bj][m][0]; x1 = x1 + gv[bj][1] * acc[ai][bj][m][1];
                        u32x4 w; w.x = xpk(x0[0], x0[1]); w.y = xpk(x0[2], x0[3]); w.z = xpk(x1[0], x1[1]); w.w = xpk(x1[2], x1[3]);
                        *(u32x4*)(out + off + bj * HALF) = w; }
                    asm volatile("" ::: "memory"); }
        } else {
#pragma unroll
            for (int ai = 0; ai < 2; ++ai)
#pragma unroll
                for (int m = 0; m < 4; ++m) { bf16_t* rowp = O + (size_t)(row0 + ai * HALF + m * 16) * 1024 + col0;
#pragma unroll
                    for (int bj = 0; bj < 2; ++bj) { const f32x4 v0 = acc[ai][bj][m][0], v1 = acc[ai][bj][m][1];
                        u32x4 w; w.x = cvt_pk_bf16(v0[0], v0[1]); w.y = cvt_pk_bf16(v0[2], v0[3]); w.z = cvt_pk_bf16(v1[0], v1[1]); w.w = cvt_pk_bf16(v1[2], v1[3]);
                        *(u32x4*)(rowp + bj * HALF) = w; } }
        }
    }
};

struct EpiSwiGLU {
    static constexpr bool PERM = true, AFTER_DRAIN = false;
    bf16_t* O; int ldc;
    __device__ __forceinline__ void operator()(const f32x4 (&acc)[2][2][4][2], const Unit& u, int wr, int wc, int fr, int fq) const {
        const int row0 = u.pm * BM + wr * 64 + fr, col0 = u.pn * HALF + wc * 32 + 8 * fq;
#pragma unroll
        for (int ai = 0; ai < 2; ++ai)
#pragma unroll
            for (int m = 0; m < 4; ++m) { bf16_t* rowp = O + (size_t)(row0 + ai * HALF + m * 16) * ldc + col0;
                const f32x4 g0 = acc[ai][0][m][0], g1 = acc[ai][0][m][1], u0 = acc[ai][1][m][0], u1 = acc[ai][1][m][1];
                const f32x4 h0 = g0 * sigmoid4(g0) * u0, h1 = g1 * sigmoid4(g1) * u1;
                u32x4 w; w.x = cvt_pk_bf16(h0[0], h0[1]); w.y = cvt_pk_bf16(h0[2], h0[3]); w.z = cvt_pk_bf16(h1[0], h1[1]); w.w = cvt_pk_bf16(h1[2], h1[3]);
                *(u32x4*)rowp = w; }
    }
};

struct EpiSwiGLU8 {
    static constexpr bool PERM = true, AFTER_DRAIN = false;
    unsigned char* O; int ldc; float s;
    __device__ __forceinline__ void operator()(const f32x4 (&acc)[2][2][4][2], const Unit& u, int wr, int wc, int fr, int fq) const {
        const int row0 = u.pm * BM + wr * 64 + fr, col0 = u.pn * HALF + wc * 32 + 8 * fq;
#pragma unroll
        for (int ai = 0; ai < 2; ++ai)
        { u32x2 w[4];
#pragma unroll
            for (int m = 0; m < 4; ++m) {
                const f32x4 g0 = acc[ai][0][m][0] * s, g1 = acc[ai][0][m][1] * s, u0 = acc[ai][1][m][0] * s, u1 = acc[ai][1][m][1] * s;
                const f32x4 h0 = g0 * sigmoid4(g0) * u0, h1 = g1 * sigmoid4(g1) * u1;
                w[m].x = pk_fp8x4(h0[0], h0[1], h0[2], h0[3]); w[m].y = pk_fp8x4(h1[0], h1[1], h1[2], h1[3]); }
#pragma unroll
            for (int k = 0; k < 2; ++k) { unsigned ax = w[k].x, bx = w[2 + k].x, ay = w[k].y, by = w[2 + k].y;
                asm volatile("v_permlane16_swap_b32 %0, %1" : "+v"(ax), "+v"(bx)); asm volatile("v_permlane16_swap_b32 %0, %1" : "+v"(ay), "+v"(by));
                u32x4 o; o.x = ax; o.y = ay; o.z = bx; o.w = by;
                *(u32x4*)(O + (size_t)(row0 + ai * HALF + (k + 2 * (fq & 1)) * 16) * ldc + (col0 - 8 * (fq & 1))) = o; } }
    }
};
struct EpiBf16S {
    static constexpr bool PERM = true, AFTER_DRAIN = false;
    bf16_t* O; float s;
    __device__ __forceinline__ void operator()(const f32x4 (&acc)[2][2][4][2], const Unit& u, int wr, int wc, int fr, int fq) const {
        const int row0 = u.pm * BM + wr * 64 + fr, col0 = u.pn * BM + wc * 32 + 8 * fq;
#pragma unroll
        for (int ai = 0; ai < 2; ++ai)
#pragma unroll
            for (int m = 0; m < 4; ++m) { bf16_t* rowp = O + (size_t)(row0 + ai * HALF + m * 16) * 1024 + col0;
#pragma unroll
                for (int bj = 0; bj < 2; ++bj) { const f32x4 v0 = acc[ai][bj][m][0] * s, v1 = acc[ai][bj][m][1] * s;
                    u32x4 w; w.x = cvt_pk_bf16(v0[0], v0[1]); w.y = cvt_pk_bf16(v0[2], v0[3]); w.z = cvt_pk_bf16(v1[0], v1[1]); w.w = cvt_pk_bf16(v1[2], v1[3]);
                    *(u32x4*)(rowp + bj * HALF) = w; } }
    }
};

typedef int v8i32 __attribute__((ext_vector_type(8))); typedef int v4i32 __attribute__((ext_vector_type(4)));
__device__ __forceinline__ void mfma_f8(f32x4& c, v8i32 a, v8i32 b) { asm volatile("v_mfma_f32_16x16x128_f8f6f4 %0, %1, %2, %0" : "+v"(c) : "v"(a), "v"(b)); }
__device__ __forceinline__ v8i32 cat32(bf16x8 a, bf16x8 b) { return __builtin_shufflevector(__builtin_bit_cast(v4i32, a), __builtin_bit_cast(v4i32, b), 0, 1, 2, 3, 4, 5, 6, 7); }
template <class Epi, class Sched, bool ALIGN_EPI = false, bool SP2 = false, bool F8 = false>
__device__ __forceinline__ void gemm_phase(PG8_LAS unsigned char* lds, const Gemm g, const Sched& S, const Epi& E, const int tid) {
    const int wid = __builtin_amdgcn_readfirstlane(tid >> 6), lane = tid & 63, wr = wid >> 2, wc = wid & 3, fr = lane & 15, fq = lane >> 4;
    const int K = g.K, nt = K / BK;
    unsigned voffA[2], voffB[2];
#pragma unroll
    for (int i = 0; i < 2; ++i) { int R, C; stage_rc(tid * 16 + i * 8192, R, C); const int Rb = Epi::PERM ? ((R & ~31) + perm32(R & 31)) : R;
        voffA[i] = (unsigned)(R * K + C) * 2u; voffB[i] = (unsigned)(Rb * K + C) * 2u; }
    const size_t kstep = (size_t)(BK * 2);
    const size_t hstep = (size_t)HALF * K * 2;
    const size_t tstep = 2 * hstep;
    const unsigned ldsw = (unsigned)wid * 1024u;
    const int aoff = lds_byte(wr * 64 + fr, fq * 8), boff = lds_byte(wc * 32 + fr, fq * 8);
#define PG8_SA(b, h) (((b) * 2 + (h)) * HTB)
#define PG8_SB(b, h) ((4 + (b) * 2 + (h)) * HTB)
#define PG8_STAGE(bufoff, gbase, voff) do { _Pragma("unroll") for (int _i = 0; _i < 2; ++_i) \
        __builtin_amdgcn_global_load_lds((const unsigned*)((const char*)(gbase) + (voff)[_i]), (PG8_LAS unsigned*)(lds + (bufoff) + ldsw + _i * 8192), 16, 0, 0); } while (0)
#define PG8_LDA(dst, b, h) do { _Pragma("unroll") for (int m = 0; m < 4; ++m) _Pragma("unroll") for (int k = 0; k < 2; ++k) dst[m][k] = *(const PG8_LAS bf16x8*)(lds + PG8_SA(b, h) + aoff + m * 2048 + k * 1024); } while (0)
#define PG8_LDB(dst, b, h) do { _Pragma("unroll") for (int n = 0; n < 2; ++n) _Pragma("unroll") for (int k = 0; k < 2; ++k) dst[n][k] = *(const PG8_LAS bf16x8*)(lds + PG8_SB(b, h) + boff + n * 2048 + k * 1024); } while (0)
#define PG8_MMA(ai, bj, At, Bt) do { __builtin_amdgcn_s_setprio(1); _Pragma("unroll") for (int m = 0; m < 4; ++m) _Pragma("unroll") for (int n = 0; n < 2; ++n) { \
        if constexpr (F8) mfma_f8(acc[ai][bj][m][n], cat32(Bt[n][0], Bt[n][1]), cat32(At[m][0], At[m][1])); \
        else { _Pragma("unroll") for (int k = 0; k < 2; ++k) acc[ai][bj][m][n] = __builtin_amdgcn_mfma_f32_16x16x32_bf16(Bt[n][k], At[m][k], acc[ai][bj][m][n], 0, 0, 0); } } __builtin_amdgcn_s_setprio(0); } while (0)
#define PG8_WAIT_V(n) asm volatile("s_waitcnt vmcnt(" #n ")" ::: "memory")
#define PG8_WAIT_L(n) asm volatile("s_waitcnt lgkmcnt(" #n ")" ::: "memory")
#define PG8_BAR __builtin_amdgcn_s_barrier()
#define PG8_SCHED __builtin_amdgcn_sched_barrier(0)
    Unit cur, nxt; int ui = 0;
    if (!S.next(0, cur)) return;
    f32x4 acc[2][2][4][2];
#pragma unroll
    for (int a = 0; a < 2; ++a)
#pragma unroll
        for (int b = 0; b < 2; ++b)
#pragma unroll
            for (int m = 0; m < 4; ++m)
#pragma unroll
                for (int n = 0; n < 2; ++n) acc[a][b][m][n] = (f32x4){0.f, 0.f, 0.f, 0.f};
    bf16x8 At[4][2], B0[2][2], B1[2][2];
    const char* cA = (const char*)g.A + (size_t)cur.pm * tstep; const char* cB = (const char*)g.Bt + (size_t)cur.pb * tstep;
    S.a_ready(cur);
    if constexpr (SP2) {
        PG8_STAGE(PG8_SB(0, 0), cB, voffB); PG8_STAGE(PG8_SB(0, 1), cB + hstep, voffB); PG8_STAGE(PG8_SA(0, 0), cA, voffA); PG8_STAGE(PG8_SA(0, 1), cA + hstep, voffA);
        if (wr == 1) PG8_BAR;
        PG8_WAIT_V(2); PG8_BAR;
        PG8_STAGE(PG8_SB(1, 0), cB + kstep, voffB); PG8_STAGE(PG8_SA(1, 0), cA + kstep, voffA); PG8_STAGE(PG8_SB(1, 1), cB + hstep + kstep, voffB);
        PG8_WAIT_V(6); PG8_BAR;
    } else {
        PG8_STAGE(PG8_SB(0, 0), cB, voffB); PG8_STAGE(PG8_SA(0, 0), cA, voffA); PG8_STAGE(PG8_SB(0, 1), cB + hstep, voffB); PG8_STAGE(PG8_SA(0, 1), cA + hstep, voffA);
        if (wr == 1) PG8_BAR;
        PG8_WAIT_V(4); PG8_BAR;
        PG8_STAGE(PG8_SB(1, 0), cB + kstep, voffB); PG8_STAGE(PG8_SA(1, 0), cA + kstep, voffA); PG8_STAGE(PG8_SB(1, 1), cB + hstep + kstep, voffB);
        PG8_WAIT_V(6); PG8_BAR;
    }
    for (;;) {
        const bool has_next = S.next(ui + 1, nxt);
        const char* nA = has_next ? (const char*)g.A + (size_t)nxt.pm * tstep : cA; const char* nB = has_next ? (const char*)g.Bt + (size_t)nxt.pb * tstep : cB;
        for (int t = 0; t < nt; t += 2) {
            const bool last = (t == nt - 2);
            const char* a1 = cA + (size_t)(t + 1) * kstep;
            const char* a2 = last ? nA : cA + (size_t)(t + 2) * kstep; const char* b2 = last ? nB : cB + (size_t)(t + 2) * kstep;
            const char* a3 = a2 + kstep; const char* b3 = b2 + kstep;
            if (last && has_next) S.a_ready(nxt);
            if constexpr (SP2) {
            PG8_LDB(B0, 0, 0); PG8_LDB(B1, 0, 1); PG8_SCHED; PG8_LDA(At, 0, 0); PG8_STAGE(PG8_SA(1, 1), a1 + hstep, voffA);
            PG8_WAIT_V(8); PG8_WAIT_L(0); PG8_BAR; PG8_MMA(0, 0, At, B0); PG8_MMA(0, 1, At, B1); PG8_BAR; PG8_SCHED;
            PG8_LDA(At, 0, 1); PG8_STAGE(PG8_SB(0, 0), b2, voffB); PG8_STAGE(PG8_SB(0, 1), b2 + hstep, voffB); PG8_STAGE(PG8_SA(0, 0), a2, voffA);
            PG8_WAIT_V(8); PG8_WAIT_L(0); PG8_BAR; PG8_MMA(1, 0, At, B0); PG8_MMA(1, 1, At, B1); PG8_BAR; PG8_SCHED;
            PG8_LDB(B0, 1, 0); PG8_LDB(B1, 1, 1); PG8_SCHED; PG8_LDA(At, 1, 0); PG8_STAGE(PG8_SA(0, 1), a2 + hstep, voffA);
            PG8_WAIT_V(8); PG8_WAIT_L(0); PG8_BAR; PG8_MMA(0, 0, At, B0); PG8_MMA(0, 1, At, B1); PG8_BAR; PG8_SCHED;
            PG8_LDA(At, 1, 1); PG8_STAGE(PG8_SB(1, 0), b3, voffB); PG8_STAGE(PG8_SB(1, 1), b3 + hstep, voffB); PG8_STAGE(PG8_SA(1, 0), a3, voffA);
            PG8_WAIT_V(8); PG8_WAIT_L(0); PG8_BAR; PG8_MMA(1, 0, At, B0); PG8_MMA(1, 1, At, B1); PG8_BAR; PG8_SCHED;
            } else {
            PG8_LDB(B0, 0, 0); PG8_SCHED; PG8_LDA(At, 0, 0); PG8_STAGE(PG8_SA(1, 1), a1 + hstep, voffA);
            PG8_WAIT_L(8); PG8_BAR; PG8_WAIT_L(0); PG8_MMA(0, 0, At, B0); PG8_BAR; PG8_SCHED;
            PG8_LDB(B1, 0, 1); PG8_STAGE(PG8_SB(0, 0), b2, voffB);
            PG8_BAR; PG8_WAIT_L(0); PG8_MMA(0, 1, At, B1); PG8_BAR;
            PG8_LDA(At, 0, 1); PG8_STAGE(PG8_SA(0, 0), a2, voffA);
            PG8_BAR; PG8_WAIT_L(0); PG8_MMA(1, 0, At, B0); PG8_BAR; PG8_SCHED;
            PG8_STAGE(PG8_SB(0, 1), b2 + hstep, voffB);
            PG8_WAIT_V(6); PG8_BAR; PG8_MMA(1, 1, At, B1); PG8_BAR;
            PG8_LDB(B0, 1, 0); PG8_SCHED; PG8_LDA(At, 1, 0); PG8_STAGE(PG8_SA(0, 1), a2 + hstep, voffA);
            PG8_WAIT_L(8); PG8_BAR; PG8_WAIT_L(0); PG8_MMA(0, 0, At, B0); PG8_BAR; PG8_SCHED;
            PG8_LDB(B1, 1, 1); PG8_STAGE(PG8_SB(1, 0), b3, voffB);
            PG8_BAR; PG8_WAIT_L(0); PG8_MMA(0, 1, At, B1); PG8_BAR;
            PG8_LDA(At, 1, 1); PG8_STAGE(PG8_SA(1, 0), a3, voffA);
            PG8_BAR; PG8_WAIT_L(0); PG8_MMA(1, 0, At, B0); PG8_BAR; PG8_SCHED;
            PG8_STAGE(PG8_SB(1, 1), b3 + hstep, voffB);
            PG8_WAIT_V(6); PG8_BAR; PG8_MMA(1, 1, At, B1); PG8_BAR;
            }
        }
        if constexpr (F8) asm volatile("s_nop 15\n\ts_nop 15\n\ts_nop 15\n\ts_nop 15" ::: "memory");
        if constexpr (ALIGN_EPI) { if (wr == 0) PG8_BAR; }
        if constexpr (!Epi::AFTER_DRAIN) { E(acc, cur, wr, wc, fr, fq); S.done(cur); }
        if (!has_next) break;
#pragma unroll
        for (int a = 0; a < 2; ++a)
#pragma unroll
            for (int b = 0; b < 2; ++b)
#pragma unroll
                for (int m = 0; m < 4; ++m)
#pragma unroll
                    for (int n = 0; n < 2; ++n) acc[a][b][m][n] = (f32x4){0.f, 0.f, 0.f, 0.f};
        cur = nxt; cA = nA; cB = nB; ++ui;
        if constexpr (ALIGN_EPI) { if (wr == 1) PG8_BAR; }
    }
    PG8_WAIT_V(0);
    if constexpr (!ALIGN_EPI) { if (wr == 0) PG8_BAR; }
    PG8_BAR;
    if constexpr (Epi::AFTER_DRAIN) { E.fused(acc, cur, wr, wc, fr, fq, lds, wid, lane); S.done(cur); }
#undef PG8_SA
#undef PG8_SB
#undef PG8_STAGE
#undef PG8_LDA
#undef PG8_LDB
#undef PG8_MMA
#undef PG8_WAIT_V
#undef PG8_WAIT_L
#undef PG8_BAR
#undef PG8_SCHED
}
}

#ifndef PG8_SP2
#define PG8_SP2 true
#endif
#ifndef PG8_ALIGN
#define PG8_ALIGN true
#endif
#include <hip/hip_bf16.h>
#include <cmath>
namespace attn_body {
using bf16=__hip_bfloat16;
using bf16x8=__attribute__((ext_vector_type(8)))short;
using s16x4=__attribute__((ext_vector_type(4)))short;
using f32x16=__attribute__((ext_vector_type(16)))float;
using u32x4=__attribute__((ext_vector_type(4)))unsigned;
using f32x4_t=__attribute__((ext_vector_type(4)))float;
constexpr int BATCH=8,NHEAD=16,SEQ=4096,D=64,DM=NHEAD*D;
constexpr int NW=8,QBLK=32,QB=QBLK*NW,KVBLK=64,NQB=SEQ/QB;
constexpr int ATTN_PITCH=DM, ATTN_UNIT_ROWS=QB;
__device__ __forceinline__ int crow(int r,int hi){return (r&3)+8*(r>>2)+4*hi;}
#define SBAR() __builtin_amdgcn_sched_barrier(0)
__device__ __forceinline__ void cmask(f32x16&p0,f32x16&p1,int jb,int qrel,int hi){
  const float NEG=-INFINITY; int kb=64*jb+4*hi;
  #pragma unroll
  for(int r=0;r<16;++r){int kv=kb+(r&3)+8*(r>>2); if(kv>qrel)p0[r]=NEG; if(kv+32>qrel)p1[r]=NEG;}
}

constexpr int NSLOT=3, SLOTB=8192;
constexpr int LDS_K=0, LDS_V=NSLOT*SLOTB, LDS_WS=2*NSLOT*SLOTB, LDS_OST=LDS_WS+NW*64*4, LDS_F=LDS_OST+NW*4096, LDS_BYTES=LDS_F+2048;
constexpr float C2=0.125f*1.4426950408889634f;
__device__ __forceinline__ void glds16(const void*gsrc,unsigned lds_dst){unsigned keep;
  asm volatile("s_mov_b32 %0, m0\n\ts_mov_b32 m0, %2\n\ts_nop 0\n\tglobal_load_lds_dwordx4 %1, off\n\ts_mov_b32 m0, %0":"=&s"(keep):"v"(gsrc),"s"(lds_dst):"memory");}
__device__ __forceinline__ void glds16s(unsigned voff,const void*sbase,unsigned lds_dst){unsigned keep;
  asm volatile("s_nop 4\n\ts_mov_b32 %0, m0\n\ts_mov_b32 m0, %3\n\ts_nop 0\n\tglobal_load_lds_dwordx4 %1, %2\n\ts_mov_b32 m0, %0":"=&s"(keep):"v"(voff),"s"(sbase),"s"(lds_dst):"memory");}
__device__ __forceinline__ void glds4s(unsigned voff,const void*sbase,unsigned lds_dst){unsigned keep;
  asm volatile("s_nop 4\n\ts_mov_b32 %0, m0\n\ts_mov_b32 m0, %3\n\ts_nop 0\n\tglobal_load_lds_dword %1, %2\n\ts_mov_b32 m0, %0":"=&s"(keep):"v"(voff),"s"(sbase),"s"(lds_dst):"memory");}
__device__ __forceinline__ void glds4(const void*gsrc,unsigned lds_dst){unsigned keep;
  asm volatile("s_mov_b32 %0, m0\n\ts_mov_b32 m0, %2\n\ts_nop 0\n\tglobal_load_lds_dword %1, off\n\ts_mov_b32 m0, %0":"=&s"(keep):"v"(gsrc),"s"(lds_dst):"memory");}
__device__ __forceinline__ float max3f(float a,float b,float c){float r;asm("v_max3_f32 %0, %1, %2, %3":"=v"(r):"v"(a),"v"(b),"v"(c));return r;}
__device__ __forceinline__ float max2f(float a,float b){float r;asm("v_max_f32_e32 %0, %1, %2":"=v"(r):"v"(a),"v"(b));return r;}
__device__ __forceinline__ float fadd_s(float a,float b){float r;asm("v_add_f32_e32 %0, %1, %2":"=v"(r):"v"(a),"v"(b));return r;}
__device__ __forceinline__ float fsub_s(float a,float b){float r;asm("v_sub_f32_e32 %0, %1, %2":"=v"(r):"v"(a),"v"(b));return r;}
typedef float f32x2_t __attribute__((ext_vector_type(2))); typedef __bf16 bf16x2_t __attribute__((ext_vector_type(2)));
__device__ __forceinline__ unsigned cvtpk_s(float lo,float hi){f32x2_t v={lo,hi};bf16x2_t b=__builtin_convertvector(v,bf16x2_t);return __builtin_bit_cast(unsigned,b);}
#define WAIT_BAR(N) asm volatile("s_waitcnt vmcnt(" #N ") lgkmcnt(0)\n\ts_barrier":::"memory")

__device__ __forceinline__ bf16x8 make_qx(float m,int hi){
  const unsigned h0=cvtpk_s(m,0.f)&0xffffu; const float r1=m-__uint_as_float(h0<<16);
  const unsigned h1=cvtpk_s(r1,0.f)&0xffffu; const float r2=r1-__uint_as_float(h1<<16);
  const unsigned h2=cvtpk_s(r2,0.f)&0xffffu;
  u32x4 w; w.x=0x3F803F80u; w.y=0x3F80u|(h0<<16); w.z=h1|(h2<<16); w.w=0u;
  if(hi){w.x=0u;w.y=0u;w.z=0u;}
  return __builtin_bit_cast(bf16x8,w);
}
__device__ __forceinline__ void qkt(f32x16&p0,f32x16&p1,const char*Kslot,const bf16x8*qr,const f32x16&negm,int r32,int hi,int xoff_,bf16x8 qx){
  const char*kb=Kslot+hi*1024+r32*16;
  #pragma unroll
  for(int d0=0;d0<4;++d0){
    const bf16x8 b0=*reinterpret_cast<const bf16x8*>(kb+d0*2048);
    const bf16x8 b1=*reinterpret_cast<const bf16x8*>(kb+d0*2048+512);
    if(d0==0){p0=__builtin_amdgcn_mfma_f32_32x32x16_bf16(b0,qr[0],negm,0,0,0);p1=__builtin_amdgcn_mfma_f32_32x32x16_bf16(b1,qr[0],negm,0,0,0);}
    else{p0=__builtin_amdgcn_mfma_f32_32x32x16_bf16(b0,qr[d0],p0,0,0,0);p1=__builtin_amdgcn_mfma_f32_32x32x16_bf16(b1,qr[d0],p1,0,0,0);}}
  const char*xb=Kslot+xoff_+r32*16;
  p0=__builtin_amdgcn_mfma_f32_32x32x16_bf16(*reinterpret_cast<const bf16x8*>(xb),qx,p0,0,0,0);p1=__builtin_amdgcn_mfma_f32_32x32x16_bf16(*reinterpret_cast<const bf16x8*>(xb+512),qx,p1,0,0,0);
}
typedef __attribute__((address_space(3))) const char* lds_cptr;
typedef short v4i16_t __attribute__((ext_vector_type(4)));
__device__ __forceinline__ void kload8(bf16x8*kf,lds_cptr kp){
  kf[0]=*(const __attribute__((address_space(3))) bf16x8*)(kp);      kf[1]=*(const __attribute__((address_space(3))) bf16x8*)(kp+512);
  kf[2]=*(const __attribute__((address_space(3))) bf16x8*)(kp+2048); kf[3]=*(const __attribute__((address_space(3))) bf16x8*)(kp+2560);
  kf[4]=*(const __attribute__((address_space(3))) bf16x8*)(kp+4096); kf[5]=*(const __attribute__((address_space(3))) bf16x8*)(kp+4608);
  kf[6]=*(const __attribute__((address_space(3))) bf16x8*)(kp+6144); kf[7]=*(const __attribute__((address_space(3))) bf16x8*)(kp+6656);
}
__device__ __forceinline__ void kload2(bf16x8*kf,lds_cptr kp,int j){ kf[2*j]=*(const __attribute__((address_space(3))) bf16x8*)(kp+j*2048); kf[2*j+1]=*(const __attribute__((address_space(3))) bf16x8*)(kp+j*2048+512); }
__device__ __forceinline__ s16x4 vtr(lds_cptr p){ return __builtin_bit_cast(s16x4,__builtin_amdgcn_ds_read_tr16_b64_v4i16((__attribute__((address_space(3))) v4i16_t*)p)); }
__device__ __forceinline__ float rowmax(const f32x16&p0,const f32x16&p1){
  float a=max3f(p0[0],p0[1],p1[0]),b=max3f(p0[2],p0[3],p1[1]);a=max3f(a,p1[2],p1[3]);
  #pragma unroll
  for(int r=4;r<16;r+=4){a=max3f(a,p0[r],p0[r+1]);b=max3f(b,p0[r+2],p0[r+3]);a=max3f(a,p1[r],p1[r+1]);b=max3f(b,p1[r+2],p1[r+3]);}
  const float m=max2f(a,b);
  auto rr=__builtin_amdgcn_permlane32_swap(__float_as_uint(m),__float_as_uint(m),false,false);
  return max2f(__uint_as_float(rr[0]),__uint_as_float(rr[1]));
}
__device__ __forceinline__ void pv(f32x16*o,int vb,bf16x8 pa0,bf16x8 pa1,bf16x8 pa2,bf16x8 pa3){
  #pragma unroll
  for(int d0=0;d0<2;++d0){s16x4 lo[4],hi[4];
    #pragma unroll
    for(int ks=0;ks<4;++ks){
      asm volatile("ds_read_b64_tr_b16 %0,%1 offset:%c2":"=&v"(lo[ks]):"v"(vb),"i"(d0*4096+ks*1024):"memory");
      asm volatile("ds_read_b64_tr_b16 %0,%1 offset:%c2":"=&v"(hi[ks]):"v"(vb),"i"(d0*4096+ks*1024+512):"memory");}
    asm volatile("s_waitcnt lgkmcnt(0)":::"memory");SBAR();
    #define PK(k) (bf16x8){lo[k][0],lo[k][1],lo[k][2],lo[k][3],hi[k][0],hi[k][1],hi[k][2],hi[k][3]}
    o[d0]=__builtin_amdgcn_mfma_f32_32x32x16_bf16(pa0,PK(0),o[d0],0,0,0);
    o[d0]=__builtin_amdgcn_mfma_f32_32x32x16_bf16(pa1,PK(1),o[d0],0,0,0);
    o[d0]=__builtin_amdgcn_mfma_f32_32x32x16_bf16(pa2,PK(2),o[d0],0,0,0);
    o[d0]=__builtin_amdgcn_mfma_f32_32x32x16_bf16(pa3,PK(3),o[d0],0,0,0);
    #undef PK
  }
}

#ifndef ATTN_STORE16
#define ATTN_STORE16(p,v) (*(u32x4*)(p)=(v))
#endif
template<int THRL> __device__ __forceinline__ void attn_unit(int b,int h,int qb,const bf16*Q,const bf16*__restrict__ K,const bf16*__restrict__ V,bf16*O,const float*__restrict__ Fh,const bf16*__restrict__ KXh,char*shm,const int tid){
  const int lane=tid&63,r32=lane&31,hi=lane>>5; const int wid=__builtin_amdgcn_readfirstlane(tid>>6);
  const long rowbase=(long)b*SEQ; const int q0=qb*QB;
  const bf16*Qw=Q+(rowbase+q0+wid*QBLK)*DM+h*D;
  const bf16*Kh=K+rowbase*DM+h*D,*Vh=V+rowbase*DM+h*D;
  const unsigned lds0=(unsigned)(uintptr_t)shm;
  float*wsf=(float*)(shm+LDS_WS)+wid*64;
  const unsigned koff=(unsigned)(lane*DM+wid*8)*2u;
  const unsigned voffv=(unsigned)((16*(wid&3)+(lane>>2))*DM+(wid>>2)*32+(lane&3)*8)*2u;
  const unsigned kdst=lds0+LDS_K+wid*1024, vdst=lds0+LDS_V+wid*1024;
  #define DMA_K(t,slot) glds16s(koff,Kh+(long)(t)*KVBLK*DM,(unsigned)__builtin_amdgcn_readfirstlane(kdst+(slot)))
  #define DMA_V(t,slot) glds16s(voffv,Vh+(long)(t)*KVBLK*DM,(unsigned)__builtin_amdgcn_readfirstlane(vdst+(slot)))
  const unsigned xdst=lds0+LDS_F+(wid&3)*256; const unsigned xoff=(unsigned)(lane*4+(wid&3)*256);
  #define DMA_KX(t) glds4s(xoff,(const char*)KXh+(long)(t)*1024,(unsigned)__builtin_amdgcn_readfirstlane(xdst+(((t)&1)*1024)))
  const lds_cptr xp0=(lds_cptr)shm+LDS_F+r32*16;
  #define KXRD(t) do{ kx0=*(const __attribute__((address_space(3))) bf16x8*)(xp0+(((t)&1)*1024)); kx1=*(const __attribute__((address_space(3))) bf16x8*)(xp0+(((t)&1)*1024)+512); }while(0)
  const int vb0=(int)(lds0+LDS_V)+((lane>>4)&1)*32+(lane&3)*8+(4*hi+((lane&15)>>2))*64;
  const char*Kbase=shm+LDS_K; bf16x8 kf[8];
  const lds_cptr shm3=(lds_cptr)shm; const lds_cptr kp0=shm3+LDS_K+hi*1024+r32*16; const lds_cptr vp0=shm3+LDS_V+((lane>>4)&1)*32+(lane&3)*8+(4*hi+((lane&15)>>2))*64;
  const int NT=(q0+QB)/KVBLK;
  DMA_KX(0);DMA_KX(1);DMA_K(0,0);DMA_V(0,0);DMA_K(1,SLOTB);
  bf16x8 qr[4];
  #pragma unroll
  for(int d0=0;d0<4;++d0)qr[d0]=*reinterpret_cast<const bf16x8*>(&Qw[(long)r32*DM+d0*16+hi*8]);
  const float fq0=Fh[q0+wid*QBLK+r32];
  float dg=0.f;
  { const bf16*Kd=Kh+(long)(q0+wid*QBLK+r32)*DM+hi*8;
    #pragma unroll
    for(int d0=0;d0<4;++d0){ const u32x4 kw=*reinterpret_cast<const u32x4*>(Kd+d0*16); const u32x4 qw=__builtin_bit_cast(u32x4,qr[d0]);
      #pragma unroll
      for(int j=0;j<4;++j){ dg+=__uint_as_float(kw[j]<<16)*__uint_as_float(qw[j]<<16); dg+=__uint_as_float(kw[j]&0xffff0000u)*__uint_as_float(qw[j]&0xffff0000u); } }
    auto rr=__builtin_amdgcn_permlane32_swap(__float_as_uint(dg),__float_as_uint(dg),false,false); dg=__uint_as_float(rr[0])+__uint_as_float(rr[1]); }
  float mhat=dg-fq0,l_reg=0.f;f32x16 o[2];o[0]=f32x16{};o[1]=f32x16{};const f32x16 negm=f32x16{};
  bf16x8 kx0,kx1;
  #define QXNOW() ({ float m_=mhat; asm volatile("":"+v"(m_)); make_qx(m_,hi); })
  const int qrel=wid*QBLK+r32;
  #define CMASK(P0,P1,t) do{int jb_=(t)-(NT-4); if(jb_>=0)cmask(P0,P1,jb_,qrel,hi);}while(0)
  bool resc=false;
  #define START(P0,P1) do{ const float rm=rowmax(P0,P1); resc=false; \
    { const float dl=max2f(rm,0.f); mhat=fadd_s(mhat,dl); \
      _Pragma("unroll") for(int r=0;r<16;++r){P0[r]=fsub_s(P0[r],dl);P1[r]=fsub_s(P1[r],dl);} \
      } \
    _Pragma("unroll") for(int r=0;r<16;++r)P0[r]=__builtin_amdgcn_exp2f(P0[r]); }while(0)
  #define RESC() do{ if(resc){ asm volatile("s_waitcnt lgkmcnt(0)":::"memory"); \
      _Pragma("unroll") for(int d_=0;d_<2;++d_) _Pragma("unroll") for(int r=0;r<16;++r)o[d_][r]*=wsf[crow(r,hi)]; } }while(0)
  f32x16 pA0,pA1,pB0,pB1;
  int sl_prev=0,sl_cur=0,sl_next=SLOTB;
  #define ROT() do{sl_prev=sl_cur;sl_cur=sl_next;sl_next=(sl_next==(NSLOT-1)*SLOTB)?0:sl_next+SLOTB;}while(0)
  DMA_K(2,2*SLOTB);
  WAIT_BAR(3);
  qkt(pA0,pA1,Kbase,qr,negm,r32,hi,LDS_F-LDS_K,QXNOW());asm volatile("s_nop 15\n\ts_nop 7":"+v"(pA0),"+v"(pA1));CMASK(pA0,pA1,0);
  START(pA0,pA1);
  _Pragma("unroll") for(int r=0;r<16;++r)pA1[r]=__builtin_amdgcn_exp2f(pA1[r]);
  WAIT_BAR(0);
  DMA_K(3,0);DMA_V(1,SLOTB);
  ROT();
  kload8(kf,kp0+sl_cur);
  WAIT_BAR(2);
  s16x4 vlo[8],vhi[8]; u32x4 pw0,pw1,pw2,pw3;
  #define PKW(P,B) cvtpk_s(P[B],P[B+1])
  #define PAF(k) __builtin_bit_cast(bf16x8,pw##k)
  #define VFR(i) (bf16x8){vlo[i][0],vlo[i][1],vlo[i][2],vlo[i][3],vhi[i][0],vhi[i][1],vhi[i][2],vhi[i][3]}
  #define PIN(x) asm volatile("":"+v"(x))
  #define MX3(a,b,c) __builtin_fmaxf(__builtin_fmaxf((a),(b)),(c))
  #define GAPA(MF,A0,A1,A2,A3,W0,W1,PW) do{ MF; sacc+=A0; sacc+=A1; sacc+=A2; sacc+=A3; PIN(sacc); W0; W1; PIN(PW); SBAR(); }while(0)
  #define EX(v) __builtin_amdgcn_exp2f(v)
  #define GAPB(MF,X,B) do{ MF; X[B]=EX(X[B]); X[B+1]=EX(X[B+1]); X[B+2]=EX(X[B+2]); X[B+3]=EX(X[B+3]); PIN(X); SBAR(); }while(0)
  #define VRD(i) do{ vlo[i]=vtr(vp_+(((i)>>2)*4096+((i)&3)*1024)); vhi[i]=vtr(vp_+(((i)>>2)*4096+((i)&3)*1024+512)); }while(0)
  #define KRD(G,j) do{ if(G){ kload2(kf,kp0+sl_next,j); SBAR(); } }while(0)
  #define STEP(C0,C1,P0,P1,t,GK,GV,GL) do{ SBAR(); if(GV){DMA_KX((t)+1);} \
    const lds_cptr vp_=vp0+sl_prev; \
    float sacc=(P0[0]+P0[1]); \
    GAPA(C0=__builtin_amdgcn_mfma_f32_32x32x16_bf16(kf[0],qr[0],negm,0,0,0), P0[2],P0[3],P0[4],P0[5],     pw0[0]=PKW(P0,0), pw0[1]=PKW(P0,2), pw0); \
    GAPA(C1=__builtin_amdgcn_mfma_f32_32x32x16_bf16(kf[1],qr[0],negm,0,0,0), P0[6],P0[7],P0[8],P0[9],     pw0[2]=PKW(P0,4), pw0[3]=PKW(P0,6), pw0); \
    GAPA(C0=__builtin_amdgcn_mfma_f32_32x32x16_bf16(kf[2],qr[1],C0,0,0,0),   P0[10],P0[11],P0[12],P0[13], pw1[0]=PKW(P0,8), pw1[1]=PKW(P0,10), pw1); \
    GAPA(C1=__builtin_amdgcn_mfma_f32_32x32x16_bf16(kf[3],qr[1],C1,0,0,0),   P0[14],P0[15],P1[0],P1[1],   pw1[2]=PKW(P0,12),pw1[3]=PKW(P0,14), pw1); \
    KXRD(t); const bf16x8 qx=QXNOW(); SBAR(); \
    GAPA(C0=__builtin_amdgcn_mfma_f32_32x32x16_bf16(kf[4],qr[2],C0,0,0,0),   P1[2],P1[3],P1[4],P1[5],     pw2[0]=PKW(P1,0), pw2[1]=PKW(P1,2), pw2); \
    GAPA(C1=__builtin_amdgcn_mfma_f32_32x32x16_bf16(kf[5],qr[2],C1,0,0,0),   P1[6],P1[7],P1[8],P1[9],     pw2[2]=PKW(P1,4), pw2[3]=PKW(P1,6), pw2); \
    GAPA(C0=__builtin_amdgcn_mfma_f32_32x32x16_bf16(kf[6],qr[3],C0,0,0,0),   P1[10],P1[11],P1[12],P1[13], pw3[0]=PKW(P1,8), pw3[1]=PKW(P1,10), pw3); \
    GAPA(C1=__builtin_amdgcn_mfma_f32_32x32x16_bf16(kf[7],qr[3],C1,0,0,0),   P1[14],P1[15],0.f,0.f,       pw3[2]=PKW(P1,12),pw3[3]=PKW(P1,14), pw3); \
    C0=__builtin_amdgcn_mfma_f32_32x32x16_bf16(kx0,qx,C0,0,0,0); SBAR(); C1=__builtin_amdgcn_mfma_f32_32x32x16_bf16(kx1,qx,C1,0,0,0); SBAR(); \
    l_reg+=sacc; \
    if(GK){DMA_K((t)+3,sl_cur);} if(GV){DMA_V((t)+1,sl_next);} \
    CMASK(C0,C1,t); \
    { float a=MX3(C0[0],C0[1],C1[0]),b=MX3(C0[2],C0[3],C1[1]); a=MX3(a,C1[2],C1[3]); \
      _Pragma("unroll") for(int r=4;r<16;r+=4){a=MX3(a,C0[r],C0[r+1]);b=MX3(b,C0[r+2],C0[r+3]);a=MX3(a,C1[r],C1[r+1]);b=MX3(b,C1[r+2],C1[r+3]);} \
      float rm=__builtin_fmaxf(a,b); { auto rr=__builtin_amdgcn_permlane32_swap(__float_as_uint(rm),__float_as_uint(rm),false,false); rm=__builtin_fmaxf(__uint_as_float(rr[0]),__uint_as_float(rr[1])); } \
      resc=false; \
      if(__builtin_expect(__any(rm>(float)THRL),0)){ const float dl=__builtin_fmaxf(rm,0.f); mhat+=dl; \
        _Pragma("unroll") for(int r=0;r<16;++r){C0[r]-=dl;C1[r]-=dl;} \
        const float f=__builtin_amdgcn_exp2f(-dl); l_reg*=f; if(hi==0)wsf[r32]=f; resc=true; } } \
    SBAR(); \
    VRD(0); VRD(4); SBAR(); VRD(1); SBAR(); GAPB(o[0]=__builtin_amdgcn_mfma_f32_32x32x16_bf16(PAF(0),VFR(0),o[0],0,0,0), C0,0); \
    VRD(5); SBAR(); GAPB(o[1]=__builtin_amdgcn_mfma_f32_32x32x16_bf16(PAF(0),VFR(4),o[1],0,0,0), C0,4); \
    KRD(GL,0); VRD(2); SBAR(); GAPB(o[0]=__builtin_amdgcn_mfma_f32_32x32x16_bf16(PAF(1),VFR(1),o[0],0,0,0), C0,8); \
    KRD(GL,1); VRD(6); SBAR(); GAPB(o[1]=__builtin_amdgcn_mfma_f32_32x32x16_bf16(PAF(1),VFR(5),o[1],0,0,0), C0,12); \
    KRD(GL,2); VRD(3); SBAR(); GAPB(o[0]=__builtin_amdgcn_mfma_f32_32x32x16_bf16(PAF(2),VFR(2),o[0],0,0,0), C1,0); \
    KRD(GL,3); VRD(7); SBAR(); GAPB(o[1]=__builtin_amdgcn_mfma_f32_32x32x16_bf16(PAF(2),VFR(6),o[1],0,0,0), C1,4); \
    GAPB(o[0]=__builtin_amdgcn_mfma_f32_32x32x16_bf16(PAF(3),VFR(3),o[0],0,0,0), C1,8); \
    GAPB(o[1]=__builtin_amdgcn_mfma_f32_32x32x16_bf16(PAF(3),VFR(7),o[1],0,0,0), C1,12); \
    }while(0)
  int t=1;
  #undef CMASK
  #define CMASK(P0,P1,t) do{}while(0)
  for(;t+5<NT;t+=2){
    STEP(pB0,pB1,pA0,pA1,t,true,true,true);     WAIT_BAR(2); RESC(); ROT();
    STEP(pA0,pA1,pB0,pB1,t+1,true,true,true);   WAIT_BAR(2); RESC(); ROT();
  }
  #undef CMASK
  #define CMASK(P0,P1,t) do{int jb_=(t)-(NT-4); if(jb_>=0)cmask(P0,P1,jb_,qrel,hi);}while(0)
  #define ENDW(tt) do{ if((tt)+3<NT){WAIT_BAR(2);} else if((tt)+2<NT){WAIT_BAR(1);} else {WAIT_BAR(0);} }while(0)
  for(;t+1<NT;t+=2){
    STEP(pB0,pB1,pA0,pA1,t,(t+3<NT),(t+1<NT),(t+1<NT));       ENDW(t);   RESC(); ROT();
    STEP(pA0,pA1,pB0,pB1,t+1,(t+4<NT),(t+2<NT),(t+2<NT));     ENDW(t+1); RESC(); ROT();
  }
  STEP(pB0,pB1,pA0,pA1,NT-1,false,false,false); RESC();
  { float sacc=pB0[0]+pB0[1]; _Pragma("unroll") for(int r=2;r<16;++r)sacc+=pB0[r]; _Pragma("unroll") for(int r=0;r<16;++r)sacc+=pB1[r]; l_reg+=sacc;
    pw0=(u32x4){PKW(pB0,0),PKW(pB0,2),PKW(pB0,4),PKW(pB0,6)};pw1=(u32x4){PKW(pB0,8),PKW(pB0,10),PKW(pB0,12),PKW(pB0,14)};pw2=(u32x4){PKW(pB1,0),PKW(pB1,2),PKW(pB1,4),PKW(pB1,6)};pw3=(u32x4){PKW(pB1,8),PKW(pB1,10),PKW(pB1,12),PKW(pB1,14)};
    SBAR(); pv(o,vb0+sl_cur,PAF(0),PAF(1),PAF(2),PAF(3)); }
  #undef PKW
  #undef PAF
  #undef VFR
  #undef PIN
  #undef MX3
  #undef GAPA
  #undef GAPB
  #undef EX
  #undef VRD
  #undef KRD
  #undef STEP
  #undef ENDW
  {auto rr=__builtin_amdgcn_permlane32_swap(__float_as_uint(l_reg),__float_as_uint(l_reg),false,false);l_reg=__uint_as_float(rr[0])+__uint_as_float(rr[1]);}
  if(hi==0)wsf[32+r32]=l_reg;asm volatile("s_waitcnt lgkmcnt(0)":::"memory");
  float rli[16];
  #pragma unroll
  for(int r=0;r<16;++r)rli[r]=__builtin_amdgcn_rcpf(wsf[32+crow(r,hi)]);
  bf16*Ow=O+(rowbase+q0+wid*QBLK)*DM+h*D;
  { bf16*stg=(bf16*)(shm+LDS_OST)+wid*2048;
    #pragma unroll
    for(int r=0;r<16;++r){const int orow=crow(r,hi);
      #pragma unroll
      for(int d0=0;d0<2;++d0)stg[orow*64+d0*32+r32]=__float2bfloat16(o[d0][r]*rli[r]);}
    asm volatile("s_waitcnt lgkmcnt(0)":::"memory");
    #pragma unroll
    for(int i=0;i<4;++i){const int row=i*8+(lane>>3),ch=lane&7; const u32x4 v=*(const u32x4*)(stg+row*64+ch*8); ATTN_STORE16(Ow+(long)row*DM+ch*8,v);} }
  asm volatile("s_waitcnt lgkmcnt(0)\n\ts_barrier":::"memory");
  #undef DMA_K
  #undef DMA_V
  #undef DMA_KX
  #undef KXRD
  #undef QXNOW
  #undef CMASK
  #undef START
  #undef RESC
  #undef ROT
}
constexpr int ATTN_LDS_BYTES=LDS_BYTES;
struct AttnTensors { const bf16* Q; const bf16* K; const bf16* V; bf16* O; const float* F; const bf16* KX; };
struct AttnUnit { int bh; int qb; };
struct StaticOrder {
  int vcu,G;
  __device__ __forceinline__ explicit StaticOrder(int grid,int v):vcu(v),G(grid){}
  __device__ __forceinline__ bool next(int i,AttnUnit&u)const{
    if(G==256){ if(i>=8)return false; const int s=(vcu&1)*4+(i>>1); u.bh=vcu>>1; u.qb=(i&1)?15-s:s; return true; }
    const int L=i*G+vcu; if(L>=BATCH*NHEAD*NQB)return false; u.bh=L/NQB; u.qb=L%NQB; return true; }
  __device__ __forceinline__ void a_ready(const AttnUnit&)const{}
  __device__ __forceinline__ void done(const AttnUnit&)const{}
};
template<class Sched,int THRL=8> __device__ __forceinline__ void attn_phase(char*lds,const AttnTensors&T,const Sched&S,const int tid){
  AttnUnit u;
  for(int i=0;S.next(i,u);++i){ S.a_ready(u); attn_unit<THRL>(u.bh/NHEAD,u.bh%NHEAD,u.qb,T.Q,T.K,T.V,T.O,T.F+(long)u.bh*SEQ,T.KX+(long)u.bh*SEQ*8,lds,tid); S.done(u); }
}
#undef SBAR
#undef WAIT_BAR
}
#define GAS __attribute__((address_space(1)))
#define LAS __attribute__((address_space(3)))
typedef unsigned short bf16;
typedef unsigned v4u __attribute__((ext_vector_type(4)));
typedef float f32x4 __attribute__((ext_vector_type(4)));
typedef short bf16x8 __attribute__((ext_vector_type(8)));
typedef GAS unsigned gu32;
typedef GAS unsigned long long gu64;
#define RLX_AGENT __ATOMIC_RELAXED, __HIP_MEMORY_SCOPE_AGENT
#define LDS_WAIT() asm volatile("s_waitcnt lgkmcnt(0)" ::: "memory")
#define VM_WAIT() asm volatile("s_waitcnt vmcnt(0)" ::: "memory")
__device__ __forceinline__ unsigned long long rt() { return __builtin_amdgcn_s_memrealtime(); }
typedef float f32x2_t __attribute__((ext_vector_type(2))); typedef __bf16 bf16x2_t __attribute__((ext_vector_type(2)));
__device__ __forceinline__ unsigned pk2(float lo, float hi) { f32x2_t v = {lo, hi}; bf16x2_t b = __builtin_convertvector(v, bf16x2_t); return __builtin_bit_cast(unsigned, b); }
__device__ __forceinline__ unsigned f2bf(float f) { return pk2(f, 0.f) & 0xffffu; }

#define XB_TMO      128
#define XB_XCNT(j)  (256  + 64 * (j))
#define XB_XSUB(j)  (1280 + 64 * (j))
#define XB_XGEN(j)  (2304 + 64 * (j))
#define XB_TOP      3328
#define XB_TOPGEN   3392
#define XCD_BAR_WORDS 3456
#define XB_SPIN_CAP (1u << 18)

__device__ __forceinline__ unsigned xb_ld(unsigned* p)              { return __hip_atomic_load(p, __ATOMIC_RELAXED, __HIP_MEMORY_SCOPE_AGENT); }
__device__ __forceinline__ unsigned xb_add(unsigned* p, unsigned v) { return __hip_atomic_fetch_add(p, v, __ATOMIC_RELAXED, __HIP_MEMORY_SCOPE_AGENT); }
__device__ __forceinline__ unsigned xb_xcc_id() { return (unsigned)__builtin_amdgcn_s_getreg((3 << 11) | 20) & 0xFu; }
#define XB_SPIN(cond, bar) do { unsigned _sp = 0; while (cond) { __builtin_amdgcn_s_sleep(1); \
    if ((++_sp & 255u) == 0u) { if (xb_ld(&(bar)[XB_TMO])) break; if (_sp > XB_SPIN_CAP) { atomicAdd(&(bar)[XB_TMO], 1u); break; } } } } while (0)

struct XcdBarrier {
    unsigned* bar; unsigned x;
    volatile LAS unsigned* st;
};

__device__ __forceinline__ XcdBarrier xcd_barrier_post(unsigned* bar, volatile LAS unsigned* st) {
    XcdBarrier b; b.bar = bar; b.x = xb_xcc_id(); b.st = st;
    if (threadIdx.x == 0) (void)xb_add(&bar[XB_XCNT(b.x)], 1u);
    return b;
}
__device__ __forceinline__ void xcd_barrier_complete(unsigned* bar, unsigned x, unsigned& nloc, unsigned& nx) {
    const unsigned G = gridDim.x * gridDim.y * gridDim.z;
    unsigned sum, cnt, mine, sp = 0u;
    for (;;) {
        sum = 0u; cnt = 0u; mine = 0u;
#pragma unroll
        for (unsigned j = 0; j < 16; ++j) { const unsigned c = xb_ld(&bar[XB_XCNT(j)]); sum += c; cnt += (c > 0u) ? 1u : 0u; mine = (j == x) ? c : mine; }
        if (sum == G) break;
        __builtin_amdgcn_s_sleep(1);
        if ((++sp & 255u) == 0u) { if (xb_ld(&bar[XB_TMO])) break; if (sp > XB_SPIN_CAP) { atomicAdd(&bar[XB_TMO], 1u); break; } }
    }
    nloc = mine > 0u ? mine : 1u; nx = cnt > 0u ? cnt : 1u;
}

__device__ __forceinline__ void xcd_barrier(const XcdBarrier& b) {
    asm volatile("s_waitcnt vmcnt(0)" ::: "memory");
    __syncthreads();
    int t0_ = threadIdx.x; asm volatile("" : "+v"(t0_));
    if (t0_ == 0) {
        unsigned* bar = b.bar;
        __builtin_amdgcn_s_waitcnt(0);
        unsigned nloc = b.st[0], nx = b.st[1];
        if (nloc == 0u) { xcd_barrier_complete(bar, b.x, nloc, nx); b.st[0] = nloc; b.st[1] = nx; }
        const unsigned old = xb_add(&bar[XB_XSUB(b.x)], 1u);
        const unsigned gen = old / nloc;
        if (old + 1u == (gen + 1u) * nloc) {
            __builtin_amdgcn_fence(__ATOMIC_RELEASE, "agent");
            asm volatile("s_waitcnt vmcnt(0)" ::: "memory");
            const unsigned og = xb_add(&bar[XB_TOP], 1u);
            const unsigned tg = og / nx;
            if (og + 1u == (tg + 1u) * nx) xb_add(&bar[XB_TOPGEN], 1u);
            else XB_SPIN(xb_ld(&bar[XB_TOPGEN]) == tg, bar);
            __builtin_amdgcn_fence(__ATOMIC_ACQUIRE, "agent");
            xb_add(&bar[XB_XGEN(b.x)], 1u);
            asm volatile("s_waitcnt vmcnt(0)" ::: "memory");
        } else {
            XB_SPIN(xb_ld(&bar[XB_XGEN(b.x)]) == gen, bar);
            __builtin_amdgcn_fence(__ATOMIC_ACQUIRE, "agent");
            asm volatile("s_waitcnt vmcnt(0)" ::: "memory");
        }
    }
    __syncthreads();
}


constexpr int NWAVES = 8;
constexpr int BATCH = 8, SEQ = 4096, D = 1024, NTOK = BATCH * SEQ;
constexpr int DEPTH = 4, D_IN = 9232, D_INP = 9472;
constexpr int DFF = 2816, NEXP = 8, DFE = 3584, NADA = 6, ADAW = NADA * D;
constexpr int NQ = 128;
constexpr float EPS = 1e-6f;
constexpr float LOG2E = 1.4426950408889634f;
constexpr int MOE_TILES_MAX = 264;

constexpr size_t MiB = 1u << 20;
constexpr size_t WS_CTL = 0, CTL_ZERO_BYTES = 1 * MiB;
constexpr size_t WS_ADAP16 = 16 * MiB;
constexpr size_t WS_ADAP = 1 * MiB;
constexpr size_t WS_ADA = 4 * MiB;
constexpr size_t WS_LB = 4 * MiB + 800 * 1024;
constexpr size_t WS_LF = 5 * MiB;
constexpr size_t WS_F = 7 * MiB;
constexpr size_t WS_DL = 9 * MiB;
constexpr size_t WS_DSC = 13 * MiB;
constexpr size_t WS_ROUTE = 13 * MiB + 512 * 1024;
constexpr size_t WS_U = 16 * MiB;
constexpr size_t WS_XB = 48 * MiB;
constexpr size_t WS_WIN = 117 * MiB;
constexpr size_t WS_WOUT = 154 * MiB;
constexpr size_t WS_WGU = 162 * MiB;
constexpr size_t WS_WDN = 184 * MiB;
constexpr size_t WS_XN = 196 * MiB;
constexpr size_t WS_ACT = 260 * MiB;
constexpr size_t ACTB = 64 * MiB;
constexpr size_t WS_INTER_D = WS_ACT;
constexpr size_t WS_INTER_M = 196 * MiB;
constexpr size_t WS_WMGU = 664 * MiB;
constexpr size_t WS_WMDN = 776 * MiB;
constexpr size_t WS_HS = 832 * MiB;
constexpr size_t WS_QF = 964 * MiB, WS_KF = 1028 * MiB;
constexpr size_t WS_KX = 1092 * MiB;
constexpr size_t WS_WIN8 = 1100 * MiB;
constexpr size_t WS_XN8 = 964 * MiB;
constexpr size_t WS_END = 1100 * MiB;
static_assert(WS_U + (size_t)512 * 4 * 64 * 64 * 4 <= WS_XB && WS_XB + (size_t)NTOK * D * 2 <= WS_WIN && WS_WIN + (size_t)4 * D_INP * D <= WS_WOUT, "d_ws map (x, in-projection weights)");
static_assert(WS_INTER_M + (size_t)MOE_TILES_MAX * 256 * DFE * 2 <= WS_WMGU && WS_HS + (size_t)MOE_TILES_MAX * 256 * D * 2 <= WS_END && WS_ACT + 11 * ACTB == WS_QF && WS_XN8 == WS_QF && WS_KF + ACTB == WS_KX, "d_ws map");
constexpr int CW_TMO = 0, CW_CODE = 1;
constexpr int CW_BAR = 4096;
constexpr int CW_CNT = 16384;

constexpr int RING_OFF = 0, RING_BYTES = 131072;
constexpr int LDSCTL_OFF = RING_BYTES, MISC_OFF = LDSCTL_OFF + 320, PTAB_OFF = LDSCTL_OFF + 1024;
constexpr int HGT_OFF = LDSCTL_OFF + 2048, HGT_PITCH = 272, HGT_BYTES = 32 * HGT_PITCH;
constexpr int LDS_BYTES = 151552;
static_assert(HGT_OFF + 2 * HGT_BYTES <= LDS_BYTES && LDS_BYTES <= 163840, "LDS map (hg tiles)");
static_assert(MISC_OFF + 128 <= LDS_BYTES, "LDS map");

struct Frame {
    LAS unsigned char* lds;
    volatile LAS unsigned* MISC;
    gu32* ctl;
    int tid, lane, wave, vcu, G;
    unsigned char* ws;
};

__device__ __forceinline__ float shfl_idx(float v, int src_lane) { return __int_as_float(__builtin_amdgcn_ds_bpermute(src_lane << 2, __float_as_int(v))); }
__device__ __forceinline__ float wave_sum(float v, int lane) {
#pragma unroll
    for (int o = 1; o < 64; o <<= 1) v += shfl_idx(v, lane ^ o);
    return v;
}
__device__ __forceinline__ float bf2f(unsigned short h) { return __uint_as_float((unsigned)h << 16); }
__device__ __forceinline__ float bflo(unsigned w) { return __uint_as_float(w << 16); }
__device__ __forceinline__ float bfhi(unsigned w) { return __uint_as_float(w & 0xffff0000u); }
__device__ __forceinline__ float sigmoidf_(float v) { return 1.0f / (1.0f + __expf(-v)); }

struct TrDesc { const float* src; bf16* dst; int ldn, nvalid, K; unsigned char* dst8; float scale; };
__device__ __forceinline__ TrDesc tr_desc(const float* W, int ldn, int s0, int nvalid, int k0, bf16* WT, int K, int d0) { TrDesc t; t.src = W + (size_t)k0 * ldn + s0; t.dst = WT + (size_t)d0 * K + k0; t.ldn = ldn; t.nvalid = nvalid; t.K = K; t.dst8 = nullptr; t.scale = 1.0f; return t; }
__device__ __forceinline__ TrDesc tr_desc8(const float* W, int ldn, int s0, int k0, unsigned char* WT8, int K, int d0, float scale, int nvalid = 32) { TrDesc t; t.src = W + (size_t)k0 * ldn + s0; t.dst = nullptr; t.ldn = ldn; t.nvalid = nvalid; t.K = K; t.dst8 = WT8 + (size_t)d0 * K + k0; t.scale = scale; return t; }
__device__ __forceinline__ void tr_load(const TrDesc& t, float (&v)[32], int lane) {
    const int n = lane & 31; const bool ok = n < (t.nvalid & 63); const int nn = (t.nvalid & 64) ? 16 * (n >> 3) + (n & 7) : n;
    const float* p = t.src + (size_t)(lane >> 5) * t.ldn + (ok ? nn : 0);
#pragma unroll
    for (int i = 0; i < 32; ++i) { const float x = p[(size_t)(2 * i) * t.ldn]; v[i] = ok ? x : 0.f; }
}
__device__ __forceinline__ void tr_store(const TrDesc& t, const float (&v)[32], LAS float* scr, int lane) {
#pragma unroll
    for (int i = 0; i < 32; ++i) scr[(2 * i + (lane >> 5)) * 33 + (lane & 31)] = v[i];
    LDS_WAIT(); asm volatile("" ::: "memory");
    const int c = lane & 7;
    if (t.dst8 != nullptr) {
        const float sc = t.scale;
#pragma unroll
        for (int j = 0; j < 4; ++j) { const int n = (lane >> 3) + 8 * j; const LAS float* s = scr + (8 * c) * 33 + n;
            pg8::u32x2 o; o.x = pg8::pk_fp8x4(s[0 * 33] * sc, s[1 * 33] * sc, s[2 * 33] * sc, s[3 * 33] * sc); o.y = pg8::pk_fp8x4(s[4 * 33] * sc, s[5 * 33] * sc, s[6 * 33] * sc, s[7 * 33] * sc);
            *(GAS pg8::u32x2*)(t.dst8 + (size_t)n * t.K + 8 * c) = o; }
    } else {
#pragma unroll
    for (int j = 0; j < 4; ++j) { const int n = (lane >> 3) + 8 * j; const LAS float* s = scr + (8 * c) * 33 + n;
        v4u o; o.x = pk2(s[0 * 33], s[1 * 33]); o.y = pk2(s[2 * 33], s[3 * 33]); o.z = pk2(s[4 * 33], s[5 * 33]); o.w = pk2(s[6 * 33], s[7 * 33]);
        *(GAS v4u*)(t.dst + (size_t)n * t.K + 8 * c) = o; }
    }
    LDS_WAIT(); asm volatile("" ::: "memory");
}
__device__ __forceinline__ TrDesc tr_gateup(const float* Wg, const float* Wu, int dff, int r, bf16* WT) {
    const int nblk = 2 * dff / 32, kb = r / nblk, db = r % nblk, p = db >> 3, q = db & 7;
    return tr_desc(q < 4 ? Wg : Wu, dff, 128 * p + 32 * (q & 3), 32, 64 * kb, WT, D, 32 * db);
}
__device__ __forceinline__ TrDesc tr_plain(const float* W, int K, int N, int r, bf16* WT) {
    const int nblk = N / 32, kb = r / nblk, db = r % nblk;
    return tr_desc(W, N, 32 * db, 32, 64 * kb, WT, K, 32 * db);
}
#define TR_LOOP(NIT_, DESC) do { float va_[32], vb_[32]; TrDesc da_, db_; int it_ = gw; if (it_ < (NIT_)) { da_ = DESC(it_); tr_load(da_, va_, F.lane); } \
    while (it_ < (NIT_)) { const int i1_ = it_ + NGW, i2_ = it_ + 2 * NGW; \
        if (i1_ < (NIT_)) { db_ = DESC(i1_); tr_load(db_, vb_, F.lane); } tr_store(da_, va_, scr, F.lane); \
        if (i1_ >= (NIT_)) break; \
        if (i2_ < (NIT_)) { da_ = DESC(i2_); tr_load(da_, va_, F.lane); } tr_store(db_, vb_, scr, F.lane); it_ = i2_; } } while (0)

enum InIdx { IN_X = 0, IN_C, IN_WADA, IN_BADA, IN_NMIX, IN_NFFN, IN_WIN, IN_QG, IN_KG, IN_FB, IN_LB, IN_OG, IN_WOUT, IN_WR, IN_BR, IN_DG, IN_DU, IN_DD, IN_MG, IN_MU, IN_MD, IN_OUT };
__device__ __forceinline__ float* gptr(const Frame& F, int k) {
    const LAS unsigned* t = (const LAS unsigned*)(F.lds + PTAB_OFF) + 2 * k; const unsigned lo = __builtin_amdgcn_readfirstlane(t[0]), hi = __builtin_amdgcn_readfirstlane(t[1]);
    return (float*)(GAS float*)(((unsigned long long)hi << 32) | lo); }

__device__ __forceinline__ void p0_prologue(Frame& F) {
    LAS float* scr = (LAS float*)(F.lds + RING_OFF + F.wave * 16384);
    const int gw = F.vcu * NWAVES + F.wave, NGW = F.G * NWAVES;
    {
        LAS float* cs = (LAS float*)(F.lds + RING_OFF + 8 * 16384 - 32768);
        const float* cp_ = gptr(F, IN_C);
        for (int i = F.tid; i < 8192; i += NWAVES * 64) { const int b = i >> 10, k = i & 1023; const float v = cp_[i]; cs[k * 8 + b] = v * sigmoidf_(v); }
        __syncthreads();
        float* P = (float*)(F.ws + WS_ADAP16);
        for (int it = F.wave * F.G + F.vcu; it < 4 * 24 * 16; it += NGW) {
            const int l = it / 384, r = it % 384, nb = r >> 4, ks = r & 15;
            f32x4 acc[8];
#pragma unroll
            for (int b = 0; b < 8; ++b) acc[b] = (f32x4){0.f, 0.f, 0.f, 0.f};
            const float* wp = gptr(F, IN_WADA) + ((size_t)l * D + ks * 64) * ADAW + nb * 256 + F.lane * 4;
#pragma unroll
            for (int kb = 0; kb < 2; ++kb) { f32x4 w[32];
#pragma unroll
                for (int k = 0; k < 32; ++k) w[k] = *(const f32x4*)(wp + (size_t)(kb * 32 + k) * ADAW);
#pragma unroll
                for (int k = 0; k < 32; ++k) { const int kk = ks * 64 + kb * 32 + k;
                    const f32x4 c0 = *(const LAS f32x4*)(cs + kk * 8), c1 = *(const LAS f32x4*)(cs + kk * 8 + 4);
                    acc[0] += c0[0] * w[k]; acc[1] += c0[1] * w[k]; acc[2] += c0[2] * w[k]; acc[3] += c0[3] * w[k]; acc[4] += c1[0] * w[k]; acc[5] += c1[1] * w[k]; acc[6] += c1[2] * w[k]; acc[7] += c1[3] * w[k]; } }
#pragma unroll
            for (int b = 0; b < 8; ++b) *(f32x4*)(P + ((size_t)(ks * 4 + l) * 8 + b) * ADAW + nb * 256 + F.lane * 4) = acc[b];
        }
        __syncthreads();
    }
    for (int c = gw * 64 + F.lane; c < 1024; c += NGW * 64) {
        const float* lbi = gptr(F, IN_LB); const float a0 = lbi[c], a1 = lbi[1024 + c], a2 = lbi[2048 + c], a3 = lbi[3072 + c];
        const float mx = fmaxf(fmaxf(a0, a1), fmaxf(a2, a3));
        const float e0 = expf(a0 - mx), e1 = expf(a1 - mx), e2 = expf(a2 - mx), e3 = expf(a3 - mx), inv = 1.0f / (e0 + e1 + e2 + e3);
        float* lb = (float*)(F.ws + WS_LB);
        lb[c] = 0.f; lb[1024 + c] = e1 * inv; lb[2048 + c] = (e1 + e2) * inv; lb[3072 + c] = (e1 + e2 + e3) * inv;
    }
    constexpr int I_IN = 16 * (D_INP / 32), I_OUT = 16 * 32, I_GU = 16 * (2 * DFF / 32), I_DN = (DFF / 64) * 32;
    constexpr int NIT = 4 * (I_IN + I_OUT) + 2 * (I_GU + I_DN);
    auto desc = [&](int it) -> TrDesc {
        int r = it;
        if (r < 4 * I_IN) { const int l = r / I_IN; r -= l * I_IN; const int kb = r / (D_INP / 32), db = r % (D_INP / 32);
            int s0, nv; if (db < 64) { s0 = 256 * (db >> 3) + 64 * (db & 3) + 32 * ((db >> 2) & 1); nv = 32; }
            else if (db < 96) { s0 = 32 * db; nv = 32; } else if (db < 160) { s0 = 256 * (db >> 3) + 16 + 64 * (db & 3) + 8 * ((db >> 2) & 1); nv = 32 | 64; }
            else if (db < 192) { s0 = 32 * db + 16; nv = 32; } else if (db < 288) { s0 = 256 * (db >> 3) + 16 + 64 * (db & 3) + 8 * ((db >> 2) & 1); nv = 32 | 64; }   else if (db == 288) { s0 = 3072; nv = 16; } else { s0 = 0; nv = 0; }
            return tr_desc8(gptr(F, IN_WIN) + (size_t)l * D * D_IN, D_IN, s0, 64 * kb, F.ws + WS_WIN + (size_t)l * D_INP * D, D, 32 * db, 32.0f, nv);
            return tr_desc(gptr(F, IN_WIN) + (size_t)l * D * D_IN, D_IN, s0, nv, 64 * kb, (bf16*)(F.ws + WS_WIN) + (size_t)l * D_INP * D, D, 32 * db); }
        r -= 4 * I_IN;
        if (r < 4 * I_OUT) { const int l = r / I_OUT; r -= l * I_OUT; return tr_plain(gptr(F, IN_WOUT) + (size_t)l * D * D, D, D, r, (bf16*)(F.ws + WS_WOUT) + (size_t)l * D * D); }
        r -= 4 * I_OUT;
        if (r < 2 * I_GU) { const int i = r / I_GU; r -= i * I_GU; return tr_gateup(gptr(F, IN_DG) + (size_t)i * D * DFF, gptr(F, IN_DU) + (size_t)i * D * DFF, DFF, r, (bf16*)(F.ws + WS_WGU) + (size_t)i * 2 * DFF * D); }
        r -= 2 * I_GU;
        { const int i = r / I_DN; r -= i * I_DN; const int nblk = D / 32, kb = r / nblk, db = r % nblk;
            return tr_desc8(gptr(F, IN_DD) + (size_t)i * DFF * D, D, 32 * db, 64 * kb, F.ws + WS_WDN + (size_t)i * D * DFF, DFF, 32 * db, 64.0f); }
    };
    TR_LOOP(NIT, desc);
}
constexpr float MOE_WS_GU = 32.0f, MOE_WS_DN = 64.0f;
__device__ __forceinline__ void moe_weights(Frame& F, int i) {
    LAS float* scr = (LAS float*)(F.lds + RING_OFF + F.wave * 16384);
    const int gw = F.vcu * NWAVES + F.wave, NGW = F.G * NWAVES;
    constexpr int I_GU = 16 * (2 * DFE / 32), I_DN = (DFE / 64) * 32, PER = I_GU + I_DN;
    auto desc = [&](int it) -> TrDesc {
        const int e = it / PER; const int r = it % PER; const size_t we = (size_t)(i * NEXP + e) * D * DFE;
        if (r < I_GU) { const int nblk = 2 * DFE / 32, kb = r / nblk, db = r % nblk, p = db >> 3, q = db & 7;
            return tr_desc8((q < 4 ? gptr(F, IN_MG) : gptr(F, IN_MU)) + we, DFE, 128 * p + 32 * (q & 3), 64 * kb, F.ws + WS_WMGU + (size_t)e * 2 * DFE * D, D, 32 * db, MOE_WS_GU); }
        { const int r2 = r - I_GU, nblk = D / 32, kb = r2 / nblk, db = r2 % nblk;
            return tr_desc8(gptr(F, IN_MD) + we, D, 32 * db, 64 * kb, F.ws + WS_WMDN + (size_t)e * D * DFE, DFE, 32 * db, MOE_WS_DN); }
    };
    TR_LOOP(NEXP * PER, desc);
}
__device__ __forceinline__ void ada_final(Frame& F) {
    const float* P = (const float*)(F.ws + WS_ADAP16); float* A = (float*)(F.ws + WS_ADA);
    const int gt = F.vcu * NWAVES * 64 + F.tid, NT = F.G * NWAVES * 64;
    const float* bad = gptr(F, IN_BADA);
    for (int i = gt; i < 4 * 8 * ADAW; i += NT) { const int l = i / (8 * ADAW), n = i % ADAW;
        float a[4] = {0.f, 0.f, 0.f, 0.f};
#pragma unroll
        for (int ks = 0; ks < 16; ++ks) a[ks & 3] += P[(size_t)ks * 4 * 8 * ADAW + i];
        A[i] = bad[l * ADAW + n] + ((a[0] + a[1]) + (a[2] + a[3])); }
}

__device__ __forceinline__ void moe_offsets(const gu32* cnt, int (&off)[9], int (&n)[8]) {
    int o = 0;
#pragma unroll
    for (int e = 0; e < 8; ++e) { n[e] = (int)__hip_atomic_load(cnt + e * 64, RLX_AGENT); off[e] = o; o += (n[e] + 255) & ~255; }
    off[8] = o;
}

template <bool ROUTE, bool COMB> __device__ __forceinline__ void row_phase(Frame& F, bool first, int lprev, int do_norm, int l) {
    constexpr bool do_route = ROUTE, do_comb = COMB; constexpr int RB = (ROUTE || COMB) ? 4 : 8;
    float* const out = gptr(F, IN_OUT); const float* const src = (const float*)gptr(F, IN_X); bf16* const XB = (bf16*)(F.ws + WS_XB);
    const float* const ada = (const float*)(F.ws + WS_ADA);
    const int moe_prev = lprev >> 1, moe_i = l >> 1;
    const float* const g2prev = ada + (size_t)lprev * 8 * ADAW + 5 * D;
    const float* const gain = (do_norm == 2 ? gptr(F, IN_NFFN) : gptr(F, IN_NMIX)) + l * D;
    const float* const sc = ada + (size_t)l * 8 * ADAW + (do_norm == 2 ? 4 : 1) * D; const float* const sh = ada + (size_t)l * 8 * ADAW + (do_norm == 2 ? 3 : 0) * D;
    const int lane = F.lane;
    bf16* XN = (bf16*)(F.ws + WS_XN);
    const bf16* DB = (const bf16*)(F.ws + WS_HS);
    const v4u* route_r = (const v4u*)(F.ws + WS_ROUTE);
    int off[9], ncnt[8];
    if (do_comb) moe_offsets(F.ctl + CW_CNT + moe_prev * 8 * 64, off, ncnt);
    LAS unsigned* lcnt = (LAS unsigned*)(F.lds + RING_OFF); LAS unsigned* gbase = lcnt + 8; LAS unsigned* rec = lcnt + 16;
    LAS f32x4* wl = (LAS f32x4*)(F.lds + RING_OFF + 4096);
    float br[8];
    if (do_route) {
        const f32x4* wsrc = (const f32x4*)(gptr(F, IN_WR) + (size_t)moe_i * D * 8);
        for (int q = F.tid; q < 2048; q += NWAVES * 64) { const int c = q >> 1, half = q & 1, j = (c >> 2) & 3, i = c & 3, ln = c >> 4; wl[((j * 4 + i) * 2 + half) * 64 + ln] = wsrc[q]; }
#pragma unroll
        for (int e = 0; e < 8; ++e) br[e] = gptr(F, IN_BR)[moe_i * 8 + e];
        __syncthreads();
    }
    for (int blk = F.vcu; blk < NTOK / NQ; blk += F.G) {
        if (do_route) { if (F.tid < 8) lcnt[F.tid] = 0u; __syncthreads(); }
        const int b = (blk * NQ) >> 12;
        for (int jr0 = 0; jr0 < 16; jr0 += RB) {
            const int rl0 = F.wave * 16 + jr0, row0 = blk * NQ + rl0;
            f32x4 v[RB][4];
#pragma unroll
            for (int r = 0; r < RB; ++r) {
                if (first) { const GAS f32x4* xr = (const GAS f32x4*)(src + (size_t)(row0 + r) * D) + 4 * lane;
#pragma unroll
                    for (int j = 0; j < 4; ++j) v[r][j] = xr[j]; }
                else { const GAS pg8::u32x4* xr = (const GAS pg8::u32x4*)(XB + (size_t)(row0 + r) * D) + 2 * lane;
#pragma unroll
                    for (int jj = 0; jj < 2; ++jj) { const pg8::u32x4 t = xr[jj]; v[r][2 * jj] = (f32x4){pg8::xlo(t.x), pg8::xhi(t.x), pg8::xlo(t.y), pg8::xhi(t.y)}; v[r][2 * jj + 1] = (f32x4){pg8::xlo(t.z), pg8::xhi(t.z), pg8::xlo(t.w), pg8::xhi(t.w)}; } } }
            if (first) {
#pragma unroll
                for (int r = 0; r < RB; ++r) { GAS pg8::u32x4* xo = (GAS pg8::u32x4*)(XB + (size_t)(row0 + r) * D) + 2 * lane;
#pragma unroll
                    for (int jj = 0; jj < 2; ++jj) { pg8::u32x4 t; t.x = pg8::xpk(v[r][2 * jj].x, v[r][2 * jj].y); t.y = pg8::xpk(v[r][2 * jj].z, v[r][2 * jj].w); t.z = pg8::xpk(v[r][2 * jj + 1].x, v[r][2 * jj + 1].y); t.w = pg8::xpk(v[r][2 * jj + 1].z, v[r][2 * jj + 1].w); xo[jj] = t; } } }
            if (do_comb) {
                v4u rt[RB];
#pragma unroll
                for (int r = 0; r < RB; ++r) rt[r] = route_r[row0 + r];
                uint2 da[RB][4], dc[RB][4];
#pragma unroll
                for (int r = 0; r < RB; ++r) { const int e1 = rt[r].x & 0xff, e2 = (rt[r].x >> 8) & 0xff;
                    int o1 = 0, o2 = 0;
#pragma unroll
                    for (int e = 0; e < 8; ++e) { o1 = (e1 == e) ? off[e] : o1; o2 = (e2 == e) ? off[e] : o2; }
                    const size_t r1 = (size_t)o1 + rt[r].y, r2 = (size_t)o2 + rt[r].z;
                    const v4u* d1 = (const v4u*)(DB + r1 * D) + 2 * lane; const v4u* d2 = (const v4u*)(DB + r2 * D) + 2 * lane;
#pragma unroll
                    for (int jj = 0; jj < 2; ++jj) { const v4u a = d1[jj], c = d2[jj]; da[r][2 * jj].x = a.x; da[r][2 * jj].y = a.y; da[r][2 * jj + 1].x = a.z; da[r][2 * jj + 1].y = a.w;
                        dc[r][2 * jj].x = c.x; dc[r][2 * jj].y = c.y; dc[r][2 * jj + 1].x = c.z; dc[r][2 * jj + 1].y = c.w; } }
                const f32x4* gp = (const f32x4*)(g2prev + (size_t)b * ADAW) + 4 * lane;
                f32x4 g[4];
#pragma unroll
                for (int j = 0; j < 4; ++j) g[j] = gp[j];
#pragma unroll
                for (int r = 0; r < RB; ++r) { const float w1 = __uint_as_float(rt[r].w), w2 = 1.0f - w1;
#pragma unroll
                    for (int j = 0; j < 4; ++j) { const uint2 a = da[r][j], c = dc[r][j];
                        f32x4 m; m[0] = w1 * bflo(a.x) + w2 * bflo(c.x); m[1] = w1 * bfhi(a.x) + w2 * bfhi(c.x); m[2] = w1 * bflo(a.y) + w2 * bflo(c.y); m[3] = w1 * bfhi(a.y) + w2 * bfhi(c.y);
                        v[r][j] = v[r][j] + g[j] * m; }
                    if (do_norm == 0) { GAS f32x4* orow = (GAS f32x4*)(out + (size_t)(row0 + r) * D) + 4 * lane;
#pragma unroll
                        for (int j = 0; j < 4; ++j) orow[j] = v[r][j]; }
                    else { GAS pg8::u32x4* xo = (GAS pg8::u32x4*)(XB + (size_t)(row0 + r) * D) + 2 * lane;
#pragma unroll
                        for (int jj = 0; jj < 2; ++jj) { pg8::u32x4 t; t.x = pg8::xpk(v[r][2 * jj].x, v[r][2 * jj].y); t.y = pg8::xpk(v[r][2 * jj].z, v[r][2 * jj].w); t.z = pg8::xpk(v[r][2 * jj + 1].x, v[r][2 * jj + 1].y); t.w = pg8::xpk(v[r][2 * jj + 1].z, v[r][2 * jj + 1].w); xo[jj] = t; } } }
            }
            if (do_norm) {
                const f32x4* gp = (const f32x4*)gain + 4 * lane; const f32x4* scp = (const f32x4*)(sc + (size_t)b * ADAW) + 4 * lane; const f32x4* shp = (const f32x4*)(sh + (size_t)b * ADAW) + 4 * lane;
                f32x4 gg[4], tt[4];
#pragma unroll
                for (int j = 0; j < 4; ++j) { gg[j] = gp[j] * (1.0f + scp[j]); tt[j] = shp[j]; }
                float s2[RB];
#pragma unroll
                for (int r = 0; r < RB; ++r) { s2[r] = 0.f;
#pragma unroll
                    for (int j = 0; j < 4; ++j) s2[r] += (v[r][j].x * v[r][j].x + v[r][j].y * v[r][j].y) + (v[r][j].z * v[r][j].z + v[r][j].w * v[r][j].w); }
#pragma unroll
                for (int o = 1; o < 64; o <<= 1)
#pragma unroll
                    for (int r = 0; r < RB; ++r) s2[r] += shfl_idx(s2[r], lane ^ o);
#pragma unroll
                for (int r = 0; r < RB; ++r) {
                    const float rstd = 1.0f / sqrtf(s2[r] * (1.f / D) + EPS);
#pragma unroll
                    for (int j = 0; j < 4; ++j) v[r][j] = (v[r][j] * rstd) * gg[j] + tt[j];
                    if (do_norm != 1) { GAS pg8::u32x4* o16 = (GAS pg8::u32x4*)(XN + (size_t)(row0 + r) * D) + 2 * lane;
#pragma unroll
                        for (int jj = 0; jj < 2; ++jj) { pg8::u32x4 t; t.x = pk2(v[r][2 * jj].x, v[r][2 * jj].y); t.y = pk2(v[r][2 * jj].z, v[r][2 * jj].w); t.z = pk2(v[r][2 * jj + 1].x, v[r][2 * jj + 1].y); t.w = pk2(v[r][2 * jj + 1].z, v[r][2 * jj + 1].w); o16[jj] = t; } }
                    if (do_norm == 1) { pg8::u32x4 t;
                        t.x = pg8::pk_fp8x4(v[r][0].x, v[r][0].y, v[r][0].z, v[r][0].w); t.y = pg8::pk_fp8x4(v[r][1].x, v[r][1].y, v[r][1].z, v[r][1].w);
                        t.z = pg8::pk_fp8x4(v[r][2].x, v[r][2].y, v[r][2].z, v[r][2].w); t.w = pg8::pk_fp8x4(v[r][3].x, v[r][3].y, v[r][3].z, v[r][3].w);
                        *((GAS pg8::u32x4*)(F.ws + WS_XN8 + (size_t)(row0 + r) * D) + lane) = t; }
                }
                if (do_route) {
                    float lg[RB][8];
#pragma unroll
                    for (int r = 0; r < RB; ++r)
#pragma unroll
                        for (int e = 0; e < 8; ++e) lg[r][e] = 0.f;
#pragma unroll
                    for (int j = 0; j < 4; ++j)
#pragma unroll
                        for (int i = 0; i < 4; ++i) { const f32x4 w0 = wl[((j * 4 + i) * 2 + 0) * 64 + lane], w1 = wl[((j * 4 + i) * 2 + 1) * 64 + lane];
#pragma unroll
                            for (int r = 0; r < RB; ++r) { const float hv = v[r][j][i];
                                lg[r][0] += hv * w0[0]; lg[r][1] += hv * w0[1]; lg[r][2] += hv * w0[2]; lg[r][3] += hv * w0[3]; lg[r][4] += hv * w1[0]; lg[r][5] += hv * w1[1]; lg[r][6] += hv * w1[2]; lg[r][7] += hv * w1[3]; } }
#pragma unroll
                    for (int o = 1; o < 64; o <<= 1)
#pragma unroll
                        for (int r = 0; r < RB; ++r)
#pragma unroll
                            for (int e = 0; e < 8; ++e) lg[r][e] += shfl_idx(lg[r][e], lane ^ o);
#pragma unroll
                    for (int r = 0; r < RB; ++r) {
                        const int rl = rl0 + r;
#pragma unroll
                        for (int e = 0; e < 8; ++e) lg[r][e] += br[e];
                        int i1 = 0; float v1 = lg[r][0];
#pragma unroll
                        for (int e = 1; e < 8; ++e) if (lg[r][e] > v1) { v1 = lg[r][e]; i1 = e; }
                        int i2 = -1; float v2 = -INFINITY;
#pragma unroll
                        for (int e = 0; e < 8; ++e) if (e != i1 && lg[r][e] > v2) { v2 = lg[r][e]; i2 = e; }
                        const float w1 = 1.0f / (1.0f + expf(v2 - v1));
                        if (lane == 0) { const unsigned s1 = __hip_atomic_fetch_add(lcnt + i1, 1u, __ATOMIC_RELAXED, __HIP_MEMORY_SCOPE_WORKGROUP), s2_ = __hip_atomic_fetch_add(lcnt + i2, 1u, __ATOMIC_RELAXED, __HIP_MEMORY_SCOPE_WORKGROUP);
                            rec[rl * 4 + 0] = (unsigned)i1 | ((unsigned)i2 << 8); rec[rl * 4 + 1] = s1; rec[rl * 4 + 2] = s2_; rec[rl * 4 + 3] = __float_as_uint(w1); }
                    }
                }
            }
        }
        if (do_route) {
            __syncthreads();
            if (F.tid < 8) gbase[F.tid] = __hip_atomic_fetch_add(F.ctl + CW_CNT + (moe_i * 8 + F.tid) * 64, lcnt[F.tid], RLX_AGENT);
            __syncthreads();
            if (F.tid < NQ) { const unsigned ee = rec[F.tid * 4]; v4u o; o.x = ee; o.y = gbase[ee & 0xff] + rec[F.tid * 4 + 1]; o.z = gbase[(ee >> 8) & 0xff] + rec[F.tid * 4 + 2]; o.w = rec[F.tid * 4 + 3];
                *(GAS v4u*)((v4u*)(F.ws + WS_ROUTE) + blk * NQ + F.tid) = o; }
            __syncthreads();
        }
    }
}

__device__ __forceinline__ void moe_scatter(Frame& F, int moe_i) {
    const int gw = F.vcu * NWAVES + F.wave, NGW = F.G * NWAVES, lane = F.lane;
    int off[9], ncnt[8]; moe_offsets(F.ctl + CW_CNT + moe_i * 8 * 64, off, ncnt);
    const v4u* route_r = (const v4u*)(F.ws + WS_ROUTE); const v4u* XN = (const v4u*)(F.ws + WS_XN); v4u* HS = (v4u*)(F.ws + WS_HS);
    for (int row = gw; row < NTOK; row += NGW) {
        const v4u rt = route_r[row]; const int e1 = rt.x & 0xff, e2 = (rt.x >> 8) & 0xff; int o1 = 0, o2 = 0;
#pragma unroll
        for (int e = 0; e < 8; ++e) { o1 = (e1 == e) ? off[e] : o1; o2 = (e2 == e) ? off[e] : o2; }
        const size_t r1 = (size_t)o1 + rt.y, r2 = (size_t)o2 + rt.z;
        const v4u a = XN[(size_t)row * 128 + 2 * lane], c = XN[(size_t)row * 128 + 2 * lane + 1];
        v4u o; o.x = pg8::pk_fp8x4(bflo(a.x), bfhi(a.x), bflo(a.y), bfhi(a.y)); o.y = pg8::pk_fp8x4(bflo(a.z), bfhi(a.z), bflo(a.w), bfhi(a.w));
        o.z = pg8::pk_fp8x4(bflo(c.x), bfhi(c.x), bflo(c.y), bfhi(c.y)); o.w = pg8::pk_fp8x4(bflo(c.z), bfhi(c.z), bflo(c.w), bfhi(c.w));
        HS[r1 * 64 + lane] = o; HS[r2 * 64 + lane] = o;
    }
    int padstart[9]; padstart[0] = 0;
#pragma unroll
    for (int e = 0; e < 8; ++e) padstart[e + 1] = padstart[e] + (((ncnt[e] + 255) & ~255) - ncnt[e]);
    for (int p = gw; p < padstart[8]; p += NGW) {
        int row = 0;
#pragma unroll
        for (int e = 0; e < 8; ++e) if (p >= padstart[e] && p < padstart[e + 1]) row = off[e] + ncnt[e] + (p - padstart[e]);
        const v4u z = (v4u){0u, 0u, 0u, 0u}; HS[(size_t)row * 64 + lane] = z;
    }
}

__host__ __device__ __forceinline__ unsigned hg_offb(unsigned row, unsigned ch) { return 256u * row + 16u * (ch ^ (((row & 3u) << 2) | ((row >> 2) & 3u))); }
__device__ __forceinline__ void prep_phase(Frame& F, int l) {
    const int gw = F.vcu * NWAVES + F.wave, NGW = F.G * NWAVES, lane = F.lane;
    unsigned char* act = F.ws + WS_ACT;
    {
        const float* LFT = (const float*)(F.ws + WS_LF); float* Fo = (float*)(F.ws + WS_F);
        for (int task = gw; task < BATCH * 16 * 16; task += NGW) {
            const int bh = task >> 4, seg = task & 15; const float* src = LFT + (size_t)bh * SEQ + 4 * lane;
            const f32x4 own = *(const f32x4*)(src + seg * 256);
            f32x4 prv[15];
#pragma unroll
            for (int q = 0; q < 15; ++q) prv[q] = *(const f32x4*)(src + (q < seg ? q : 0) * 256);
            float part = 0.f;
#pragma unroll
            for (int q = 0; q < 15; ++q) part += (q < seg) ? ((prv[q][0] + prv[q][1]) + (prv[q][2] + prv[q][3])) : 0.f;
            const float off = wave_sum(part, lane);
            const float c0 = own[0], c1 = c0 + own[1], c2 = c1 + own[2], c3 = c2 + own[3];
            float pre = c3;
#pragma unroll
            for (int o = 1; o < 64; o <<= 1) { const float t = shfl_idx(pre, lane - o); if (lane >= o) pre += t; }
            const float base = off + (pre - c3);
            const f32x4 fv = (f32x4){(base + c0) * LOG2E, (base + c1) * LOG2E, (base + c2) * LOG2E, (base + c3) * LOG2E};
            *(f32x4*)(Fo + (size_t)bh * SEQ + seg * 256 + 4 * lane) = fv;
            v4u* kx = (v4u*)(F.ws + WS_KX) + (size_t)bh * SEQ + seg * 256 + 4 * lane;
#pragma unroll
            for (int i = 0; i < 4; ++i) { const float nf = -fv[i];
                const unsigned h0 = f2bf(nf); const float r1 = nf - __uint_as_float(h0 << 16); const unsigned h1 = f2bf(r1); const float r2 = r1 - __uint_as_float(h1 << 16); const unsigned h2 = f2bf(r2);
                kx[i] = (v4u){h0 | (h1 << 16), h2 | 0xBF800000u, 0xBF80BF80u, 0u}; }
        }
    }
    {
        LAS unsigned char* sb = F.lds + RING_OFF + F.wave * 16384;
        LAS unsigned short* Zs = (LAS unsigned short*)sb; LAS unsigned short* Qs = (LAS unsigned short*)(sb + 4608);
        const unsigned char* HQ = act + 3 * ACTB; const unsigned char* HF = act + 4 * ACTB;
        LAS unsigned char* Z8 = sb + 9216; LAS unsigned char* Q8 = sb + 9216 + 2560;
        float* DL = (float*)(F.ws + WS_DL);
        const float* lbp = (const float*)(F.ws + WS_LB) + l * 1024;
        const int r = lane >> 1, c0 = (lane & 1) * 32;
        v4u nz[2], nq[2];
        if (gw < 1024 * 16) { const size_t ro0 = ((size_t)(gw >> 4) * 32 + r) * D + 64 * (gw & 15) + c0; const v4u* pz = (const v4u*)(HF + ro0); const v4u* pq = (const v4u*)(HQ + ro0);
#pragma unroll
            for (int k = 0; k < 2; ++k) { nz[k] = pz[k]; nq[k] = pq[k]; } }
        for (int it = gw; it < 1024 * 16; it += NGW) {
            const int ck = it >> 4, cg = it & 15;
            {
#pragma unroll
                for (int k = 0; k < 2; ++k) { *(LAS v4u*)(Z8 + r * 80 + c0 + 16 * k) = nz[k]; *(LAS v4u*)(Q8 + r * 80 + c0 + 16 * k) = nq[k]; }
                const int itn = it + NGW;
                if (itn < 1024 * 16) { const size_t ron = ((size_t)(itn >> 4) * 32 + r) * D + 64 * (itn & 15) + c0; const v4u* pz = (const v4u*)(HF + ron); const v4u* pq = (const v4u*)(HQ + ron);
#pragma unroll
                    for (int k = 0; k < 2; ++k) { nz[k] = pz[k]; nq[k] = pq[k]; } }
            }
            LDS_WAIT(); __builtin_amdgcn_wave_barrier(); asm volatile("" ::: "memory");
            {
                const int ch = 64 * cg + lane; const float lb = lbp[ch], oml = 1.0f - lb;
                float E = 1.0f;
#pragma unroll
                for (int t = 0; t < 32; ++t) {
                    const float z = __builtin_amdgcn_cvt_f32_fp8((int)Z8[t * 80 + lane], 0), qr_ = __builtin_amdgcn_cvt_f32_fp8((int)Q8[t * 80 + lane], 0), q = qr_ * pg8::sigmoid_f(qr_);
                    const float e = __builtin_amdgcn_exp2f(-LOG2E * z), inv = __builtin_amdgcn_rcpf(1.0f + e);
                    const float f = fmaxf(lb + oml * inv, 1e-20f), kk = oml * (e * inv);
                    E *= f;
                    const float qt = q * E, ktv = kk * fminf(__builtin_amdgcn_rcpf(E), 5.540622e34f);
                    Qs[t * 72 + lane] = (unsigned short)f2bf(qt); Zs[t * 72 + lane] = (unsigned short)f2bf(ktv);
                }
                DL[(size_t)ck * 1024 + ch] = E;
            }
            LDS_WAIT(); __builtin_amdgcn_wave_barrier(); asm volatile("" ::: "memory");
            {
                unsigned char* tq = F.ws + WS_QF + (size_t)(ck * 8 + (cg >> 1)) * 8192; unsigned char* tk = F.ws + WS_KF + (size_t)(ck * 8 + (cg >> 1)) * 8192;
#pragma unroll
                for (int k = 0; k < 4; ++k) { const int chunk = 8 * (cg & 1) + 4 * (lane & 1) + k; const unsigned o = hg_offb((unsigned)r, (unsigned)chunk);
                    *(v4u*)(tq + o) = *(const LAS v4u*)(Qs + r * 72 + c0 + 8 * k); *(v4u*)(tk + o) = *(const LAS v4u*)(Zs + r * 72 + c0 + 8 * k); }
            }
            LDS_WAIT(); __builtin_amdgcn_wave_barrier(); asm volatile("" ::: "memory");
        }
    }
}

typedef float f32x16 __attribute__((ext_vector_type(16)));
#define MFMA32(a, b, c) __builtin_amdgcn_mfma_f32_32x32x16_bf16(a, b, c, 0, 0, 0)
__device__ __forceinline__ bf16x8 pack8(const f32x16& x, int s) {
    v4u w; w.x = pk2(x[8 * s], x[8 * s + 1]); w.y = pk2(x[8 * s + 2], x[8 * s + 3]); w.z = pk2(x[8 * s + 4], x[8 * s + 5]); w.w = pk2(x[8 * s + 6], x[8 * s + 7]);
    return __builtin_bit_cast(bf16x8, w);
}
constexpr int HG_NSC = 8, HG_CPS = 16, HG_UNITS = 64 * HG_NSC;
template <bool OUT> __device__ __forceinline__ void hg_pipe(Frame& F, int l) {
    const int lane = F.lane, r32 = lane & 31, hi = lane >> 5;
    const int grp = F.wave >> 2, vb = F.wave & 3;
    unsigned char* act = F.ws + WS_ACT;
    const unsigned char* QTg = F.ws + WS_QF; const unsigned char* KTg = F.ws + WS_KF; const unsigned char* HIg = act + 5 * ACTB;
    bf16* OH = (bf16*)(act + 5 * ACTB); const float* DL = (const float*)(F.ws + WS_DL);
    float* U = (float*)(F.ws + WS_U); float* DSC = (float*)(F.ws + WS_DSC);
    const unsigned ldsg = (unsigned)(uintptr_t)(F.lds + RING_OFF) + (unsigned)grp * 65536u;
    const LAS unsigned char* lg = F.lds + RING_OFF + grp * 65536;
    const unsigned voff = (unsigned)lane * 16u;
    typedef short v4i16_t __attribute__((ext_vector_type(4)));
    const int rpi = (r32 & ~12) | ((r32 & 4) << 1) | ((r32 & 8) >> 1);
    const int xq = ((r32 & 3) << 2) | ((r32 >> 2) & 3), xk = ((rpi & 3) << 2) | ((rpi >> 2) & 3);
    const int trr0 = 8 * hi + ((lane & 15) >> 2), trcb = 2 * ((lane >> 4) & 1) + ((lane & 3) >> 1), trp8 = 8 * (lane & 1);
    const int trx0 = ((trr0 & 3) << 2) | ((2 * hi) & 3);
    LAS unsigned char* tile = F.lds + HGT_OFF + grp * HGT_BYTES;
    const int mtok = 8 * vb + (lane >> 3), mcol = (lane & 7) * 16;
    const float* ogp = gptr(F, IN_OG) + l * 128 + mcol;
    v4u mi[2], mh[1], mg[2];
#define HG_MLOAD(tokc_) do { const size_t ro_ = ((size_t)((tokc_) + mtok) * D + 128 * h + mcol) * 2; \
        mi[0] = *(const v4u*)(act + 0 * ACTB + ro_); mi[1] = *(const v4u*)(act + 0 * ACTB + ro_ + 16); mh[0] = *(const v4u*)(act + 6 * ACTB + (ro_ >> 1)); \
        _Pragma("unroll") for (int g_ = 0; g_ < 2; ++g_) mg[g_] = *(const v4u*)(act + (size_t)(7 + g_) * ACTB + (ro_ >> 1)); } while (0)
#define HG_MERGE(tokc_) do { float oh_[16]; \
        _Pragma("unroll") for (int q_ = 0; q_ < 2; ++q_) { const v4u w_ = *(const LAS v4u*)(tile + mtok * HGT_PITCH + mcol * 2 + 16 * q_); \
            oh_[8 * q_] = bflo(w_.x); oh_[8 * q_ + 1] = bfhi(w_.x); oh_[8 * q_ + 2] = bflo(w_.y); oh_[8 * q_ + 3] = bfhi(w_.y); oh_[8 * q_ + 4] = bflo(w_.z); oh_[8 * q_ + 5] = bfhi(w_.z); oh_[8 * q_ + 6] = bflo(w_.w); oh_[8 * q_ + 7] = bfhi(w_.w); } \
        float ss_ = 0.f; _Pragma("unroll") for (int i_ = 0; i_ < 16; ++i_) ss_ += oh_[i_] * oh_[i_]; \
        ss_ += shfl_idx(ss_, lane ^ 1); ss_ += shfl_idx(ss_, lane ^ 2); ss_ += shfl_idx(ss_, lane ^ 4); \
        const float rstd_ = 1.0f / sqrtf(ss_ * (1.0f / 128.0f) + EPS); \
        const size_t ro_ = ((size_t)((tokc_) + mtok) * D + 128 * h + mcol) * 2; \
        _Pragma("unroll") for (int q_ = 0; q_ < 2; ++q_) { const f32x4 g0_ = *(const f32x4*)(ogp + 8 * q_), g1_ = *(const f32x4*)(ogp + 8 * q_ + 4); const float og_[8] = {g0_[0], g0_[1], g0_[2], g0_[3], g1_[0], g1_[1], g1_[2], g1_[3]}; \
            const unsigned aw_[4] = {mi[q_].x, mi[q_].y, mi[q_].z, mi[q_].w}; const int gw_[2] = {(int)(q_ ? mh[0].z : mh[0].x), (int)(q_ ? mh[0].w : mh[0].y)}; \
            const unsigned ga_[2] = {q_ ? mg[0].z : mg[0].x, q_ ? mg[0].w : mg[0].y}, gb_[2] = {q_ ? mg[1].z : mg[1].x, q_ ? mg[1].w : mg[1].y}; \
            float y_[8]; _Pragma("unroll") for (int p_ = 0; p_ < 4; ++p_) { const float h0_ = (p_ & 1) ? __builtin_amdgcn_cvt_f32_fp8(gw_[p_ >> 1], 2) : __builtin_amdgcn_cvt_f32_fp8(gw_[p_ >> 1], 0), h1_ = (p_ & 1) ? __builtin_amdgcn_cvt_f32_fp8(gw_[p_ >> 1], 3) : __builtin_amdgcn_cvt_f32_fp8(gw_[p_ >> 1], 1); \
                const float a0_ = __builtin_fmaf((float)((ga_[p_ >> 1] >> (16 * (p_ & 1))) & 0xffu), 16.0f / 255.0f, -8.0f), a1_ = __builtin_fmaf((float)((ga_[p_ >> 1] >> (16 * (p_ & 1) + 8)) & 0xffu), 16.0f / 255.0f, -8.0f); \
                const float b0_ = __builtin_fmaf((float)((gb_[p_ >> 1] >> (16 * (p_ & 1))) & 0xffu), 16.0f / 255.0f, -8.0f), b1_ = __builtin_fmaf((float)((gb_[p_ >> 1] >> (16 * (p_ & 1) + 8)) & 0xffu), 16.0f / 255.0f, -8.0f); \
                y_[2 * p_] = pg8::sigmoid_f(a0_) * bflo(aw_[p_]) + pg8::sigmoid_f(b0_) * (oh_[8 * q_ + 2 * p_] * rstd_ * og_[2 * p_] * (h0_ * pg8::sigmoid_f(h0_))); \
                y_[2 * p_ + 1] = pg8::sigmoid_f(a1_) * bfhi(aw_[p_]) + pg8::sigmoid_f(b1_) * (oh_[8 * q_ + 2 * p_ + 1] * rstd_ * og_[2 * p_ + 1] * (h1_ * pg8::sigmoid_f(h1_))); } \
            *(v4u*)(F.ws + WS_XN + ro_ + 16 * q_) = (v4u){pk2(y_[0], y_[1]), pk2(y_[2], y_[3]), pk2(y_[4], y_[5]), pk2(y_[6], y_[7])}; } } while (0)
    const int ntrip = (HG_UNITS + 2 * F.G - 1) / (2 * F.G);
    for (int trip = 0; trip < ntrip; ++trip) {
        const int unit = (trip * F.G + F.vcu) * 2 + grp; const bool live = unit < HG_UNITS;
        const int bh = unit >> 3, sc = unit & 7, b = bh >> 3, h = bh & 7;
        const int tok0 = b * SEQ + sc * (32 * HG_CPS), ck0 = tok0 >> 5;
#define HG_DMA(j, bi) do { if (live) { const size_t go_ = ((size_t)(ck0 + (j)) * 8 + h) * 8192; const unsigned lb_ = ldsg + (unsigned)(bi) * 32768u; \
            const unsigned char* vs_ = HIg + ((size_t)(tok0 + 32 * (j)) * D + 128 * h) * 2; \
            _Pragma("unroll") for (int pp_ = 0; pp_ < 2; ++pp_) { const int pc_ = vb + 4 * pp_; \
                if (OUT) attn_body::glds16s(voff, QTg + go_ + pc_ * 1024, (unsigned)__builtin_amdgcn_readfirstlane(lb_ + pc_ * 1024)); \
                attn_body::glds16s(voff, KTg + go_ + pc_ * 1024, (unsigned)__builtin_amdgcn_readfirstlane(lb_ + 8192 + pc_ * 1024)); \
                  \
                { const unsigned vo_ = (unsigned)((4 * pc_ + (lane >> 4)) * 2048 + 16 * ((lane & 15) ^ (((lane >> 4) << 2) | (pc_ & 3)))); \
                  attn_body::glds16s(vo_, vs_, (unsigned)__builtin_amdgcn_readfirstlane(lb_ + 16384 + pc_ * 1024)); } } \
              \
            if (vb == 0) attn_body::glds16s(voff, (const unsigned char*)(DL + (size_t)(ck0 + (j)) * 1024 + 128 * h), (unsigned)__builtin_amdgcn_readfirstlane(lb_ + 24576)); } } while (0)
#define HG_ROWF(bi, toff, row, x, ch) (*(const LAS bf16x8*)(lg + (bi) * 32768 + (toff) + 256 * (row) + 16 * ((ch) ^ (x))))
#define HG_TRF(dst, bi, toff, c, ks) do { v4i16_t lo_, hi_; \
            { const int ch0_ = (4 * (c) + trcb) ^ trx0, ch1_ = (4 * (c) + trcb) ^ (trx0 | 1); \
              lo_ = __builtin_amdgcn_ds_read_tr16_b64_v4i16((LAS v4i16_t*)(lg + (bi) * 32768 + (toff) + 256 * (16 * (ks) + trr0) + 16 * ch0_ + trp8)); \
              hi_ = __builtin_amdgcn_ds_read_tr16_b64_v4i16((LAS v4i16_t*)(lg + (bi) * 32768 + (toff) + 256 * (16 * (ks) + trr0 + 4) + 16 * ch1_ + trp8)); } \
            dst = (bf16x8){lo_[0], lo_[1], lo_[2], lo_[3], hi_[0], hi_[1], hi_[2], hi_[3]}; } while (0)
        HG_DMA(0, 0);
        f32x16 S[4];
#pragma unroll
        for (int kb = 0; kb < 4; ++kb) S[kb] = f32x16{};
        if (OUT && live) {
            for (int j = 0; j < sc; ++j) { const int uj = bh * HG_NSC + j;
#pragma unroll
                for (int kb = 0; kb < 4; ++kb) { const float* dp = DSC + (size_t)uj * 128 + 32 * kb + 4 * hi; const f32x4 d0 = *(const f32x4*)dp, d1 = *(const f32x4*)(dp + 8), d2 = *(const f32x4*)(dp + 16), d3 = *(const f32x4*)(dp + 24);
                    const float dd[16] = {d0[0], d0[1], d0[2], d0[3], d1[0], d1[1], d1[2], d1[3], d2[0], d2[1], d2[2], d2[3], d3[0], d3[1], d3[2], d3[3]};
                    const unsigned* up = (const unsigned*)U + (((size_t)uj * 4 + vb) * 32 + kb * 8) * 64 + lane;
                    unsigned uw[8];
#pragma unroll
                    for (int rp = 0; rp < 8; ++rp) uw[rp] = up[(size_t)rp * 64];
#pragma unroll
                    for (int rp = 0; rp < 8; ++rp) { S[kb][2 * rp] = S[kb][2 * rp] * dd[2 * rp] + pg8::xlo(uw[rp]); S[kb][2 * rp + 1] = S[kb][2 * rp + 1] * dd[2 * rp + 1] + pg8::xhi(uw[rp]); } } }
        }
        asm volatile("s_waitcnt vmcnt(0) lgkmcnt(0)\n\ts_barrier" ::: "memory");
        for (int j = 0; j < HG_CPS; ++j) {
            const int bi = j & 1, ck = ck0 + j, tokc = tok0 + 32 * j;
            if (OUT && live && j > 0) HG_MERGE(tokc - 32);
            if (j + 1 < HG_CPS) HG_DMA(j + 1, bi ^ 1);
            if (OUT) { asm volatile("s_waitcnt lgkmcnt(0)\n\ts_barrier" ::: "memory");
                       if (live) HG_MLOAD(tokc); }
            if (live) {
                bf16x8 vt[2];
#pragma unroll
                for (int st = 0; st < 2; ++st) HG_TRF(vt[st], bi, 16384, vb, st);
                if (OUT) {
                    f32x16 X = f32x16{};
#pragma unroll
                    for (int ks = 0; ks < 8; ++ks) X = MFMA32(HG_ROWF(bi, 8192, rpi, xk, 2 * ks + hi), HG_ROWF(bi, 0, r32, xq, 2 * ks + hi), X);
#pragma unroll
                    for (int r = 0; r < 16; ++r) { const int s_ = 16 * (r >> 3) + 8 * hi + (r & 7); X[r] = (s_ > r32) ? 0.f : X[r]; }
                    const bf16x8 P0 = pack8(X, 0), P1 = pack8(X, 1);
                    f32x16 o = f32x16{};
                    o = MFMA32(P0, vt[0], o); o = MFMA32(P1, vt[1], o);
#pragma unroll
                    for (int kb = 0; kb < 4; ++kb)
#pragma unroll
                        for (int hf_ = 0; hf_ < 2; ++hf_) { const int s_ = 2 * kb + hf_;
                            const pg8::u32x2 qa_ = *(const LAS pg8::u32x2*)(lg + bi * 32768 + 256 * r32 + 16 * ((2 * s_) ^ xq) + 8 * hi), qb_ = *(const LAS pg8::u32x2*)(lg + bi * 32768 + 256 * r32 + 16 * ((2 * s_ + 1) ^ xq) + 8 * hi);
                            o = MFMA32(__builtin_bit_cast(bf16x8, (v4u){qa_.x, qa_.y, qb_.x, qb_.y}), pack8(S[kb], hf_), o); }
#pragma unroll
                    for (int r = 0; r < 16; ++r) { const int t = 8 * (r >> 2) + 4 * hi + (r & 3); *(LAS unsigned short*)(tile + t * HGT_PITCH + (32 * vb + r32) * 2) = (unsigned short)f2bf(o[r]); }
                }
#pragma unroll
                for (int kb = 0; kb < 4; ++kb) {
#pragma unroll
                    for (int st = 0; st < 2; ++st) { bf16x8 kf_; HG_TRF(kf_, bi, 8192, kb, st); S[kb] = MFMA32(kf_, vt[st], S[kb]); }
                    const LAS float* dp = (const LAS float*)(lg + bi * 32768 + 24576) + 32 * kb + 4 * hi; const f32x4 d0 = *(const LAS f32x4*)dp, d1 = *(const LAS f32x4*)(dp + 8), d2 = *(const LAS f32x4*)(dp + 16), d3 = *(const LAS f32x4*)(dp + 24);
                    const float dd[16] = {d0[0], d0[1], d0[2], d0[3], d1[0], d1[1], d1[2], d1[3], d2[0], d2[1], d2[2], d2[3], d3[0], d3[1], d3[2], d3[3]};
#pragma unroll
                    for (int r = 0; r < 16; ++r) S[kb][r] *= dd[r];
                }
            }
            asm volatile("s_waitcnt vmcnt(0) lgkmcnt(0)\n\ts_barrier" ::: "memory");
        }
        if (OUT && live) HG_MERGE(tok0 + 32 * (HG_CPS - 1));
        if (OUT) asm volatile("s_waitcnt lgkmcnt(0)\n\ts_barrier" ::: "memory");
        if (!OUT && live) {
#pragma unroll
            for (int kb = 0; kb < 4; ++kb) { unsigned* up = (unsigned*)U + (((size_t)unit * 4 + vb) * 32 + kb * 8) * 64 + lane;
#pragma unroll
                for (int rp = 0; rp < 8; ++rp) up[(size_t)rp * 64] = pg8::xpk(S[kb][2 * rp], S[kb][2 * rp + 1]); }
            if (vb == 0) {
#pragma unroll
                for (int half = 0; half < 2; ++half) { const int ch = lane + 64 * half; float p = 1.0f;
                    for (int j = 0; j < HG_CPS; ++j) p *= DL[(size_t)(ck0 + j) * 1024 + 128 * h + ch];
                    DSC[(size_t)unit * 128 + ch] = p; }
            }
        }
#undef HG_DMA
#undef HG_ROWF
#undef HG_TRF
    }
    asm volatile("s_waitcnt vmcnt(0) lgkmcnt(0)" ::: "memory");
#undef HG_MLOAD
#undef HG_MERGE
}
template <bool OUT> __device__ __forceinline__ void hg_phase(Frame& F, int l) { hg_pipe<OUT>(F, l); }

__device__ __forceinline__ void merge_phase(Frame& F, int l) {
    const int gw = F.vcu * NWAVES + F.wave, NGW = F.G * NWAVES, lane = F.lane;
    unsigned char* act = F.ws + WS_ACT;
    float og[16];
#pragma unroll
    for (int i = 0; i < 16; ++i) og[i] = gptr(F, IN_OG)[l * 128 + (lane & 7) * 16 + i];
    for (int row = gw; row < NTOK; row += NGW) {
        const size_t ro = (size_t)row * 2048 + 32 * lane;
        const v4u* pa = (const v4u*)(act + 0 * ACTB + ro); const v4u* ph = (const v4u*)(act + 5 * ACTB + ro); const v4u* pg = (const v4u*)(act + 6 * ACTB + ro);
        const v4u* pga = (const v4u*)(act + 7 * ACTB + ro); const v4u* pgb = (const v4u*)(act + 8 * ACTB + ro);
        v4u out[2]; float oh[16];
#pragma unroll
        for (int k = 0; k < 2; ++k) { const v4u w = ph[k]; oh[8 * k] = bflo(w.x); oh[8 * k + 1] = bfhi(w.x); oh[8 * k + 2] = bflo(w.y); oh[8 * k + 3] = bfhi(w.y); oh[8 * k + 4] = bflo(w.z); oh[8 * k + 5] = bfhi(w.z); oh[8 * k + 6] = bflo(w.w); oh[8 * k + 7] = bfhi(w.w); }
        float ss = 0.f;
#pragma unroll
        for (int i = 0; i < 16; ++i) ss += oh[i] * oh[i];
        ss += shfl_idx(ss, lane ^ 1); ss += shfl_idx(ss, lane ^ 2); ss += shfl_idx(ss, lane ^ 4);
        const float rstd = 1.0f / sqrtf(ss * (1.0f / 128.0f) + EPS);
#pragma unroll
        for (int k = 0; k < 2; ++k) { const v4u wa = pa[k], wg = pg[k], wga = pga[k], wgb = pgb[k]; float y[8];
            const unsigned aw[4] = {wa.x, wa.y, wa.z, wa.w}, gw_[4] = {wg.x, wg.y, wg.z, wg.w}, gaw[4] = {wga.x, wga.y, wga.z, wga.w}, gbw[4] = {wgb.x, wgb.y, wgb.z, wgb.w};
#pragma unroll
            for (int q = 0; q < 4; ++q) {
                const float g0 = bflo(gw_[q]), g1 = bfhi(gw_[q]);
                y[2 * q] = pg8::sigmoid_f(bflo(gaw[q])) * bflo(aw[q]) + pg8::sigmoid_f(bflo(gbw[q])) * (oh[8 * k + 2 * q] * rstd * og[8 * k + 2 * q] * (g0 * pg8::sigmoid_f(g0)));
                y[2 * q + 1] = pg8::sigmoid_f(bfhi(gaw[q])) * bfhi(aw[q]) + pg8::sigmoid_f(bfhi(gbw[q])) * (oh[8 * k + 2 * q + 1] * rstd * og[8 * k + 2 * q + 1] * (g1 * pg8::sigmoid_f(g1))); }
            out[k] = (v4u){pk2(y[0], y[1]), pk2(y[2], y[3]), pk2(y[4], y[5]), pk2(y[6], y[7])}; }
        v4u* po = (v4u*)(F.ws + WS_XN + ro); po[0] = out[0]; po[1] = out[1];
    }
}

struct Args { const float* in[21]; float* out; unsigned char* ws; int ph_lo, ph_hi; };
__global__ void __launch_bounds__(NWAVES * 64, 2) trunk_fwd(Args args) {
    extern __shared__ __attribute__((aligned(16))) unsigned char lds[];
    Frame F;
    F.lds = (LAS unsigned char*)lds;
    F.MISC = (volatile LAS unsigned*)(F.lds + MISC_OFF);
    F.tid = threadIdx.x; F.lane = F.tid & 63; F.wave = __builtin_amdgcn_readfirstlane(F.tid >> 6);
    F.G = gridDim.x; { const int bx = blockIdx.x; F.vcu = (F.G % 8 == 0) ? (bx % 8) * (F.G / 8) + bx / 8 : bx; }
    F.ws = args.ws; F.ctl = (gu32*)(args.ws + WS_CTL);
    for (int u = F.tid; u < (LDS_BYTES - LDSCTL_OFF) / 4; u += NWAVES * 64) ((LAS unsigned*)(F.lds + LDSCTL_OFF))[u] = 0u;
    __syncthreads();
    if (F.tid < 22) { const unsigned long long p = (F.tid < 21) ? (unsigned long long)args.in[F.tid] : (unsigned long long)args.out;
        LAS unsigned* t = (LAS unsigned*)(F.lds + PTAB_OFF) + 2 * F.tid; t[0] = (unsigned)p; t[1] = (unsigned)(p >> 32); }
    __syncthreads();
    XcdBarrier bar = xcd_barrier_post((unsigned*)(F.ctl + CW_BAR), F.MISC + 8);
#define GRID_BAR() do { XcdBarrier b_ = bar; { GAS unsigned* g_ = (GAS unsigned*)b_.bar; asm volatile("" : "+s"(g_)); b_.bar = (unsigned*)g_; } xcd_barrier(b_); } while (0)
    const int lo = args.ph_lo, hi = args.ph_hi; int ph = 0;
#define PHASE_BEGIN if (ph >= lo && ph < hi) { Frame P = F; asm volatile("" : "+v"(P.tid)); asm volatile("" : "+s"(P.vcu), "+s"(P.G)); { GAS unsigned char* g_ = (GAS unsigned char*)P.ws; asm volatile("" : "+s"(g_)); P.ws = (unsigned char*)g_; } P.lane = P.tid & 63; P.wave = __builtin_amdgcn_readfirstlane(P.tid >> 6); P.ctl = (gu32*)P.ws;
#define PHASE_END   if (ph + 1 < hi) GRID_BAR(); } ++ph;
#ifndef REP_MASK
#define REP_MASK 0
#endif
#define REPEAT(bit) for (int rep_ = 0; rep_ < ((REP_MASK & (bit)) ? 2 : 1); ++rep_)

    PHASE_BEGIN REPEAT(4) { p0_prologue(P); __syncthreads(); } PHASE_END
    PHASE_BEGIN ada_final(P); PHASE_END

    for (int l = 0; l < DEPTH; ++l) {
        const bool moe = (l & 1); const int fi = l >> 1;
        PHASE_BEGIN if ((l > 0) && ((l - 1) & 1)) row_phase<false, true>(P, false, l - 1, 1, l); else row_phase<false, false>(P, l == 0, 0, 1, l); PHASE_END
        PHASE_BEGIN {
            { pg8::Gemm g{(const bf16*)(P.ws + WS_XN8), (const bf16*)(P.ws + WS_WIN + (size_t)l * D_INP * D), NTOK, D_INP, D / 2}; pg8::TileOrder S; S.init(NTOK / 256, D_INP / 256, P.G, (int)blockIdx.x); S.tmode = 2;
              float sc_ = 1.0f / 32.0f; asm volatile("" : "+s"(sc_));
              pg8::EpiInProj E{(bf16*)(P.ws + WS_ACT), ACTB / 2, (float*)(P.ws + WS_LF), gptr(P, IN_FB) + l * 16, gptr(P, IN_QG) + l * 64, gptr(P, IN_KG) + l * 64, sc_};
              REPEAT(1) { int tid_ = P.tid; asm volatile("" : "+v"(tid_)); pg8::gemm_phase<pg8::EpiInProj, pg8::TileOrder, PG8_ALIGN, PG8_SP2, true>(P.lds + RING_OFF, g, S, E, tid_); } }
        } PHASE_END
        PHASE_BEGIN prep_phase(P, l); PHASE_END
        PHASE_BEGIN {
            if ((((int)blockIdx.x >> 3) & 1) == 0) { REPEAT(16) hg_phase<false>(P, l); asm volatile("s_waitcnt vmcnt(0) lgkmcnt(0)" ::: "memory"); __syncthreads(); }
            {
                unsigned char* act = P.ws + WS_ACT;
                REPEAT(2) {
                const attn_body::AttnTensors AT{(const attn_body::bf16*)(act + 0 * ACTB), (const attn_body::bf16*)(act + 1 * ACTB), (const attn_body::bf16*)(act + 2 * ACTB), (attn_body::bf16*)(((REP_MASK & 2) && rep_ == 0) ? P.ws + WS_XN : act + 0 * ACTB), (const float*)(P.ws + WS_F), (const attn_body::bf16*)(P.ws + WS_KX)};
                const attn_body::StaticOrder S((int)P.G, P.vcu);
                attn_body::attn_phase<attn_body::StaticOrder>((char*)lds + RING_OFF, AT, S, P.tid);
                }
            }
            if ((((int)blockIdx.x >> 3) & 1) != 0) { asm volatile("s_waitcnt vmcnt(0) lgkmcnt(0)" ::: "memory"); __syncthreads();
                Frame P2 = F; asm volatile("" : "+v"(P2.tid)); asm volatile("" : "+s"(P2.vcu), "+s"(P2.G)); { GAS unsigned char* g_ = (GAS unsigned char*)P2.ws; asm volatile("" : "+s"(g_)); P2.ws = (unsigned char*)g_; }
                P2.lane = P2.tid & 63; P2.wave = __builtin_amdgcn_readfirstlane(P2.tid >> 6); P2.ctl = (gu32*)P2.ws;
                REPEAT(16) hg_phase<false>(P2, l); }
        } PHASE_END
        PHASE_BEGIN REPEAT(32) hg_phase<true>(P, l); PHASE_END
        PHASE_BEGIN {
            pg8::Gemm g{(const bf16*)(P.ws + WS_XN), (const bf16*)(P.ws + WS_WOUT) + (size_t)l * D * D, NTOK, D, D}; pg8::TileOrder S; S.init(NTOK / 256, D / 256, P.G, (int)blockIdx.x);
            bf16* const xb = (bf16*)(P.ws + WS_XB);
            pg8::EpiResid E{xb, xb, (const float*)(P.ws + WS_ADA) + (size_t)l * 8 * ADAW + 2 * D, ADAW, nullptr, 0, 1.0f};
            pg8::gemm_phase<pg8::EpiResid, pg8::TileOrder, PG8_ALIGN, PG8_SP2>(P.lds + RING_OFF, g, S, E, P.tid);
        } PHASE_END
        PHASE_BEGIN if (moe) row_phase<true, false>(P, false, 0, 2, l); else row_phase<false, false>(P, false, 0, 2, l); if (moe) { __syncthreads(); REPEAT(4) moe_weights(P, fi); } PHASE_END
        if (moe) { PHASE_BEGIN moe_scatter(P, fi); PHASE_END }
        PHASE_BEGIN {
            pg8::TileOrder S;
            if (moe) { int off[9], ncnt[8]; moe_offsets(P.ctl + CW_CNT + fi * 8 * 64, off, ncnt); S.init(off[8] >> 8, 2 * DFE / 256, P.G, (int)blockIdx.x); S.nbt = 2 * DFE / 256;
#pragma unroll
                for (int e = 0; e < 8; ++e) S.cum[e] = off[e] >> 8;
                const pg8::Gemm g{(const bf16*)(P.ws + WS_HS), (const bf16*)(P.ws + WS_WMGU), off[8], 2 * DFE, D / 2};
                float sc_ = 1.0f / MOE_WS_GU; asm volatile("" : "+s"(sc_));
                const pg8::EpiSwiGLU8 E{P.ws + WS_INTER_M, DFE, sc_};
                REPEAT(8) { int tid_ = P.tid; asm volatile("" : "+v"(tid_)); pg8::gemm_phase<pg8::EpiSwiGLU8, pg8::TileOrder, PG8_ALIGN, PG8_SP2, true>(P.lds + RING_OFF, g, S, E, tid_); }
            } else {
                S.init(NTOK / 256, 2 * DFF / 256, P.G, (int)blockIdx.x);
                const pg8::Gemm g{(const bf16*)(P.ws + WS_XN), (const bf16*)(P.ws + WS_WGU) + (size_t)fi * 2 * DFF * D, NTOK, 2 * DFF, D};
                float one_ = 1.0f; asm volatile("" : "+s"(one_));
                const pg8::EpiSwiGLU8 E{P.ws + WS_INTER_D, DFF, one_};
                REPEAT(8) { int tid_ = P.tid; asm volatile("" : "+v"(tid_)); pg8::gemm_phase<pg8::EpiSwiGLU8, pg8::TileOrder, PG8_ALIGN, PG8_SP2>(P.lds + RING_OFF, g, S, E, tid_); }
            }
        } PHASE_END
        PHASE_BEGIN {
            pg8::TileOrder S;
            if (moe) { int off[9], ncnt[8]; moe_offsets(P.ctl + CW_CNT + fi * 8 * 64, off, ncnt); S.init(off[8] >> 8, D / 256, P.G, (int)blockIdx.x); S.nbt = D / 256;
#pragma unroll
                for (int e = 0; e < 8; ++e) S.cum[e] = off[e] >> 8;
                const pg8::Gemm g{(const bf16*)(P.ws + WS_INTER_M), (const bf16*)(P.ws + WS_WMDN), off[8], D, DFE / 2};
                float sc_ = 1.0f / MOE_WS_DN; asm volatile("" : "+s"(sc_));
                const pg8::EpiBf16S E{(bf16*)(P.ws + WS_HS), sc_};
                for (int rep_ = 0; rep_ < ((REP_MASK & 8) ? 2 : 1); ++rep_) { int tid_ = P.tid; asm volatile("" : "+v"(tid_)); pg8::gemm_phase<pg8::EpiBf16S, pg8::TileOrder, PG8_ALIGN, PG8_SP2, true>(P.lds + RING_OFF, g, S, E, tid_); }
            } else {
                S.init(NTOK / 256, D / 256, P.G, (int)blockIdx.x);
                bf16* const xb = (bf16*)(P.ws + WS_XB);
                const pg8::Gemm g{(const bf16*)(P.ws + WS_INTER_D), (const bf16*)(P.ws + WS_WDN + (size_t)fi * D * DFF), NTOK, D, DFF / 2};
                float sc_ = 1.0f / MOE_WS_DN; asm volatile("" : "+s"(sc_));
                const pg8::EpiResid E{xb, xb, (const float*)(P.ws + WS_ADA) + (size_t)l * 8 * ADAW + 5 * D, ADAW, nullptr, 0, sc_};
                { int tid_ = P.tid; asm volatile("" : "+v"(tid_)); pg8::gemm_phase<pg8::EpiResid, pg8::TileOrder, PG8_ALIGN, PG8_SP2, true>(P.lds + RING_OFF, g, S, E, tid_); }
            }
        } PHASE_END
    }
    PHASE_BEGIN row_phase<false, true>(P, false, 3, 0, 0); PHASE_END
#undef PHASE_BEGIN
#undef PHASE_END
}

#ifndef MK_SPLIT
#define MK_SPLIT 0
#endif
constexpr int N_PHASES = 2 + 4 * 9 + 2 * 1 + 1;
extern "C" void kernel_launch(void* const* d_in, const int* in_sizes, int n_in, void* d_out, int out_size, void* d_ws, size_t ws_size, hipStream_t stream) {
    static int grid = 0;
    if (grid == 0) {
        if (n_in != 21 || out_size != NTOK * D || ws_size < WS_END) { fprintf(stderr, "kernel_launch: unexpected sizes (n_in %d out %d ws %zu need %zu)\n", n_in, out_size, ws_size, (size_t)WS_END); grid = -1; return; }
        int dev = 0, cus = 0, per_cu = 0;
        if (hipGetDevice(&dev) != hipSuccess || hipDeviceGetAttribute(&cus, hipDeviceAttributeMultiprocessorCount, dev) != hipSuccess) { grid = -1; return; }
        if (hipFuncSetAttribute((const void*)trunk_fwd, hipFuncAttributeMaxDynamicSharedMemorySize, LDS_BYTES) != hipSuccess) { grid = -1; return; }
        if (hipOccupancyMaxActiveBlocksPerMultiprocessor(&per_cu, (const void*)trunk_fwd, NWAVES * 64, LDS_BYTES) != hipSuccess || per_cu < 1) fprintf(stderr, "kernel_launch: occupancy query says %d\n", per_cu);
        (void)hipGetLastError();
        grid = cus;
    }
    if (grid < 0) return;
    if (hipMemsetAsync((char*)d_ws + WS_CTL, 0, CTL_ZERO_BYTES, stream) != hipSuccess) return;
    Args a{};
    for (int i = 0; i < 21; ++i) a.in[i] = (const float*)d_in[i];
    a.out = (float*)d_out; a.ws = (unsigned char*)d_ws;
#if MK_SPLIT
    for (int p = 0; p < N_PHASES; ++p) { a.ph_lo = p; a.ph_hi = p + 1; hipLaunchKernelGGL(trunk_fwd, dim3(grid), dim3(NWAVES * 64), LDS_BYTES, stream, a); }
#else
    a.ph_lo = 0; a.ph_hi = N_PHASES;
    hipLaunchKernelGGL(trunk_fwd, dim3(grid), dim3(NWAVES * 64), LDS_BYTES, stream, a);
#endif
}
```
